# Optimizing an MI355X kernel written in HIP

```python
import jax, jax.numpy as jnp
from jax import lax
import numpy as np

D_MODEL = 1024
BATCH = 16
SEQ = 2048
DEPTH = 4

EPS = 1e-6
HEAD_DIM = 64
GLA_HEADS = 4
GLA_DK = 48
GLA_DV = 96
GLA_WIDTH = GLA_HEADS * GLA_DV
GLA_GATE_RANK = 16
GLA_GATE_TEMP = 16.0
GLA_CHUNK = 64
LRU_WIDTH = 256
LRU_BLOCKS = 8
LRU_BLOCK = LRU_WIDTH // LRU_BLOCKS
LRU_C = 8.0
LRU_CONV = 4
SWA_HEADS = 6
SWA_WIDTH = SWA_HEADS * HEAD_DIM
DILATED_PATTERNS = ((128, 1), (512, 4), (2048, 16))
SWA_BLOCK = 128
ROPE_THETA = 500000.0
ROPE_DIM = HEAD_DIM // 4
MIX_WIDTH = GLA_WIDTH + LRU_WIDTH + SWA_WIDTH
FFN_DIM = 2816
FFN_CONV = 3
IN_SPLITS = (GLA_HEADS * GLA_DK, GLA_HEADS * GLA_DK, GLA_WIDTH, GLA_WIDTH, GLA_GATE_RANK,
             LRU_WIDTH, LRU_WIDTH, SWA_WIDTH, SWA_WIDTH, SWA_WIDTH)
IN_COLS = sum(IN_SPLITS)

kernel_name = 'hymba_style_gla_rglru_dilated_swa_trunk'


def rms_norm(x, g):
    xf = x.astype(jnp.float32)
    y = xf * lax.rsqrt(jnp.mean(xf * xf, axis=-1, keepdims=True) + EPS)
    return (y * g).astype(x.dtype)


def causal_dwconv(x, w, b):
    K = w.shape[0]
    S = x.shape[1]
    xp = jnp.pad(x, ((0, 0), (K - 1, 0), (0, 0)))
    y = b + xp[:, K - 1:K - 1 + S] * w[K - 1]
    for k in range(K - 1):
        y = y + xp[:, k:k + S] * w[k]
    return y


def rope_tables(S):
    inv = ROPE_THETA ** (-jnp.arange(0, ROPE_DIM, 2, dtype=jnp.float32) / ROPE_DIM)
    ang = jnp.arange(S, dtype=jnp.float32)[:, None] * inv[None, :]
    return jnp.cos(ang), jnp.sin(ang)


def partial_rope(x, cos, sin):
    xr, xpass = x[..., :ROPE_DIM], x[..., ROPE_DIM:]
    x1, x2 = xr[..., :ROPE_DIM // 2], xr[..., ROPE_DIM // 2:]
    c = cos[None, :, None, :]
    s = sin[None, :, None, :]
    rot = jnp.concatenate([x1 * c - x2 * s, x2 * c + x1 * s], axis=-1).astype(x.dtype)
    return jnp.concatenate([rot, xpass], axis=-1)


def gla_chunked(q, k, v, g):
    B, S, H, dk = q.shape
    dv = v.shape[-1]
    C = GLA_CHUNK
    n = S // C

    def to_chunks(t):
        return t.astype(jnp.float32).reshape(B, n, C, H, t.shape[-1]).transpose(1, 0, 3, 2, 4)

    qc = to_chunks(q) * (dk ** -0.5)
    kc, vc, gc = to_chunks(k), to_chunks(v), to_chunks(g)
    causal = jnp.tril(jnp.ones((C, C), dtype=bool))

    def step(state, inp):
        qb, kb, vb, gb = inp
        b = jnp.cumsum(gb, axis=2)
        o_inter = jnp.einsum('bhik,bhkv->bhiv', qb * jnp.exp(b), state)
        diff = b[:, :, :, None, :] - b[:, :, None, :, :]
        decay = jnp.exp(jnp.where(causal[:, :, None], diff, -jnp.inf))
        scores = jnp.einsum('bhik,bhjk,bhijk->bhij', qb, kb, decay)
        o_intra = jnp.einsum('bhij,bhjv->bhiv', scores, vb)
        b_last = b[:, :, -1]
        k_dec = kb * jnp.exp(b_last[:, :, None, :] - b)
        state = jnp.exp(b_last)[..., None] * state + jnp.einsum('bhjk,bhjv->bhkv', k_dec, vb)
        return state, o_inter + o_intra

    state0 = jnp.zeros((B, H, dk, dv), jnp.float32)
    _, out = lax.scan(step, state0, (qc, kc, vc, gc))
    return out.transpose(1, 0, 3, 2, 4).reshape(B, S, H, dv)


def rg_lru(x, w_a, b_a, w_x, b_x, lam):
    B, S, W = x.shape
    xf = x.astype(jnp.float32)
    xb = xf.reshape(B, S, LRU_BLOCKS, LRU_BLOCK)
    r = jax.nn.sigmoid(jnp.einsum('bsni,nij->bsnj', xb, w_a).reshape(B, S, W) + b_a)
    i = jax.nn.sigmoid(jnp.einsum('bsni,nij->bsnj', xb, w_x).reshape(B, S, W) + b_x)
    log_a = -LRU_C * r * jax.nn.softplus(-lam)
    a = jnp.exp(log_a)
    u = jnp.sqrt(-jnp.expm1(2.0 * log_a)) * (i * xf)

    def combine(c1, c2):
        a1, b1 = c1
        a2, b2 = c2
        return a1 * a2, a2 * b1 + b2

    _, h = lax.associative_scan(combine, (a, u), axis=1)
    return h.astype(x.dtype)


def banded_causal_attention(q, k, v, span):
    N, L, H, hd = q.shape
    nb = -(-L // SWA_BLOCK)
    Lp = nb * SWA_BLOCK
    pad = ((0, 0), (0, Lp - L), (0, 0), (0, 0))
    q, k, v = (jnp.pad(t, pad) for t in (q, k, v))
    qb = q.reshape(N, nb, SWA_BLOCK, H, hd)

    def with_prev(t):
        tb = t.reshape(N, nb, SWA_BLOCK, H, hd)
        prev = jnp.pad(tb, ((0, 0), (1, 0), (0, 0), (0, 0), (0, 0)))[:, :-1]
        return jnp.concatenate([prev, tb], axis=2)

    kb, vb = with_prev(k), with_prev(v)
    s = jnp.einsum('nbqhd,nbkhd->nbhqk', qb, kb).astype(jnp.float32) * (hd ** -0.5)
    qi = jnp.arange(SWA_BLOCK)[:, None]
    kj = jnp.arange(2 * SWA_BLOCK)[None, :]
    dist = qi + SWA_BLOCK - kj
    blk = jnp.arange(nb)[:, None, None]
    valid = (dist >= 0) & (dist <= span) & (blk * SWA_BLOCK + kj - SWA_BLOCK >= 0)
    s = jnp.where(valid[None, :, None], s, -jnp.inf)
    m = jnp.max(s, axis=-1, keepdims=True)
    p = jnp.exp(s - m)
    denom = jnp.sum(p, axis=-1, keepdims=True)
    o = jnp.einsum('nbhqk,nbkhd->nbqhd', p / denom, vb.astype(jnp.float32))
    lse = (m + jnp.log(denom))[..., 0].transpose(0, 1, 3, 2)
    return o.reshape(N, Lp, H, hd)[:, :L], lse.reshape(N, Lp, H)[:, :L]


def dilated_attention(q, k, v):
    B, S, H, hd = q.shape
    outs, lses = [], []
    for window, dil in DILATED_PATTERNS:
        L = S // dil

        def to_sub(t):
            return t.reshape(B, L, dil, H, hd).transpose(0, 2, 1, 3, 4).reshape(B * dil, L, H, hd)

        o, lse = banded_causal_attention(to_sub(q), to_sub(k), to_sub(v), window // dil)
        outs.append(o.reshape(B, dil, L, H, hd).transpose(0, 2, 1, 3, 4).reshape(B, S, H, hd))
        lses.append(lse.reshape(B, dil, L, H).transpose(0, 2, 1, 3).reshape(B, S, H))
    w = jax.nn.softmax(jnp.stack(lses, axis=0), axis=0)
    return jnp.einsum('pbsh,pbshd->bshd', w, jnp.stack(outs, axis=0))


def _normal(k, shape, scale):
    return jax.random.normal(k, shape, jnp.float32) * scale


def _gain(k, shape):
    return 1.0 + 0.1 * jax.random.normal(k, shape, jnp.float32)


def setup_inputs(seed: int = 0) -> dict:
    key = jax.random.key(seed)
    ks = jax.random.split(key, 22)
    a0 = jax.random.uniform(ks[12], (DEPTH, LRU_WIDTH), jnp.float32, minval=0.9, maxval=0.999)
    a_base = a0 ** (1.0 / LRU_C)
    lru_lambda = jnp.log(a_base) - jnp.log1p(-a_base)
    return {
        'x': jax.random.normal(ks[0], (BATCH, SEQ, D_MODEL), jnp.float32),
        'norm_mix': _gain(ks[1], (DEPTH, D_MODEL)),
        'w_in': _normal(ks[2], (DEPTH, D_MODEL, IN_COLS), D_MODEL ** -0.5),
        'gla_w_gate': _normal(ks[3], (DEPTH, GLA_GATE_RANK, GLA_HEADS * GLA_DK), GLA_GATE_RANK ** -0.5),
        'gla_b_gate': _normal(ks[4], (DEPTH, GLA_HEADS * GLA_DK), 0.1),
        'gla_norm': _gain(ks[5], (DEPTH, GLA_DV)),
        'lru_conv_w': _normal(ks[6], (DEPTH, LRU_CONV, LRU_WIDTH), LRU_CONV ** -0.5),
        'lru_conv_b': _normal(ks[7], (DEPTH, LRU_WIDTH), 0.02),
        'lru_w_a': _normal(ks[8], (DEPTH, LRU_BLOCKS, LRU_BLOCK, LRU_BLOCK), LRU_BLOCK ** -0.5),
        'lru_b_a': _normal(ks[9], (DEPTH, LRU_WIDTH), 0.1),
        'lru_w_x': _normal(ks[10], (DEPTH, LRU_BLOCKS, LRU_BLOCK, LRU_BLOCK), LRU_BLOCK ** -0.5),
        'lru_b_x': _normal(ks[11], (DEPTH, LRU_WIDTH), 0.1),
        'lru_lambda': lru_lambda,
        'lru_norm': _gain(ks[13], (DEPTH, LRU_WIDTH)),
        'swa_norm': _gain(ks[14], (DEPTH, SWA_WIDTH)),
        'w_out': _normal(ks[15], (DEPTH, MIX_WIDTH, D_MODEL), MIX_WIDTH ** -0.5),
        'norm_ffn': _gain(ks[16], (DEPTH, D_MODEL)),
        'ffn_w_up': _normal(ks[17], (DEPTH, D_MODEL, 2 * FFN_DIM), D_MODEL ** -0.5),
        'ffn_conv_w': _normal(ks[18], (DEPTH, FFN_CONV, 2 * FFN_DIM), FFN_CONV ** -0.5),
        'ffn_conv_b': _normal(ks[19], (DEPTH, 2 * FFN_DIM), 0.02),
        'ffn_w_down': _normal(ks[20], (DEPTH, FFN_DIM, D_MODEL), FFN_DIM ** -0.5),
        'norm_final': _gain(ks[21], (D_MODEL,)),
    }


def reference(x, norm_mix, w_in, gla_w_gate, gla_b_gate, gla_norm, lru_conv_w, lru_conv_b,
              lru_w_a, lru_b_a, lru_w_x, lru_b_x, lru_lambda, lru_norm, swa_norm, w_out,
              norm_ffn, ffn_w_up, ffn_conv_w, ffn_conv_b, ffn_w_down, norm_final):
    B, S, _ = x.shape
    cos, sin = rope_tables(S)
    split_points = np.cumsum(IN_SPLITS)[:-1].tolist()
    for l in range(DEPTH):
        h = rms_norm(x, norm_mix[l])
        proj = h @ w_in[l]
        a_q, a_k, a_v, a_r, a_glr, b_gate, b_in, c_q, c_k, c_v = jnp.split(proj, split_points, axis=-1)

        g = jax.nn.log_sigmoid((a_glr @ gla_w_gate[l] + gla_b_gate[l]).astype(jnp.float32)) / GLA_GATE_TEMP
        o_a = gla_chunked(a_q.reshape(B, S, GLA_HEADS, GLA_DK), a_k.reshape(B, S, GLA_HEADS, GLA_DK),
                          a_v.reshape(B, S, GLA_HEADS, GLA_DV), g.reshape(B, S, GLA_HEADS, GLA_DK))
        o_a = rms_norm(o_a.astype(x.dtype), gla_norm[l]).reshape(B, S, GLA_WIDTH) * jax.nn.silu(a_r)

        u = causal_dwconv(b_in, lru_conv_w[l], lru_conv_b[l])
        h_rec = rg_lru(u, lru_w_a[l], lru_b_a[l], lru_w_x[l], lru_b_x[l], lru_lambda[l])
        o_b = rms_norm(h_rec * jax.nn.gelu(b_gate), lru_norm[l])

        q = partial_rope(c_q.reshape(B, S, SWA_HEADS, HEAD_DIM), cos, sin)
        k = partial_rope(c_k.reshape(B, S, SWA_HEADS, HEAD_DIM), cos, sin)
        o_c = dilated_attention(q, k, c_v.reshape(B, S, SWA_HEADS, HEAD_DIM))
        o_c = rms_norm(o_c.astype(x.dtype).reshape(B, S, SWA_WIDTH), swa_norm[l])

        x = x + jnp.concatenate([o_a, o_b, o_c], axis=-1) @ w_out[l]

        h = rms_norm(x, norm_ffn[l])
        up = causal_dwconv(h @ ffn_w_up[l], ffn_conv_w[l], ffn_conv_b[l])
        u_val, u_gate = jnp.split(up, 2, axis=-1)
        x = x + (jax.nn.gelu(u_gate) * u_val) @ ffn_w_down[l]
    return rms_norm(x, norm_final)
```

```cpp
#include <hip/hip_runtime.h>
#include <cstdio>
#include <cstdint>
namespace pg8 {
#define PG8_LAS __attribute__((address_space(3)))
typedef unsigned short bf16_t;
typedef short bf16x8 __attribute__((ext_vector_type(8)));
typedef float f32x4 __attribute__((ext_vector_type(4)));
typedef unsigned u32x4 __attribute__((ext_vector_type(4)));
constexpr int BM = 256, BK = 64, HALF = 128, HTB = HALF * BK * 2  , STAGE_BYTES = 8 * HTB, NXCD = 8, WGM = 8;

__host__ __device__ __forceinline__ int lds_byte(int r, int c) { const int st = (r >> 4) * 2 + (c >> 5), rr = r & 15, cc = c & 31, ob = rr * 64 + cc * 2; return st * 1024 + (ob ^ (((ob >> 9) & 1) << 5)); }
__host__ __device__ __forceinline__ void stage_rc(int b, int& R, int& C) { const int st = b / 1024, sb = b % 1024, swz = sb ^ (((sb >> 9) & 1) << 5); R = (st >> 1) * 16 + swz / 64; C = (st & 1) * 32 + (swz % 64) / 2; }
__host__ __device__ __forceinline__ int perm32(int rho) { const int n = rho >> 4, i = rho & 15; return 8 * (i >> 2) + 4 * n + (i & 3); }

struct Unit { int pm, pn; };
struct Gemm { const bf16_t* A; const bf16_t* Bt; int M, N, K; };

struct StaticOrder {
    int nM, nN, nwg, G, c;
    __host__ __device__ void init(int M, int N, int G_, int c_) { nM = M / BM; nN = N / BM; nwg = nM * nN; G = G_; c = c_; }
    __host__ __device__ bool next(int i, Unit& u) const {
        const long L = (long)i * G + c; if (L >= nwg) return false;
        int wgid = (int)L; { const int q = nwg / NXCD, r = nwg % NXCD, xcd = wgid % NXCD, off = wgid / NXCD; wgid = (xcd < r ? xcd * (q + 1) : r * (q + 1) + (xcd - r) * q) + off; }
        const int nig = WGM * nN, gid = wgid / nig, fm = gid * WGM, gsz = (nM - fm) < WGM ? (nM - fm) : WGM;
        u.pm = fm + ((wgid % nig) % gsz); u.pn = (wgid % nig) / gsz; return true;
    }
    __device__ __forceinline__ void a_ready(const Unit&) const {}
    __device__ __forceinline__ void done(const Unit&) const {}
};

__device__ __forceinline__ unsigned cvt_pk_bf16(float lo, float hi) { unsigned r; asm volatile("v_cvt_pk_bf16_f32 %0, %1, %2" : "=v"(r) : "v"(lo), "v"(hi)); return r; }
typedef float f32x2 __attribute__((ext_vector_type(2)));
__device__ __forceinline__ f32x2 gelu_pk(f32x2 v) {
    const f32x2 av = __builtin_elementwise_abs(v), d = av * 0.2316418882f + 1.0f;
    f32x2 t; t.x = __builtin_amdgcn_rcpf(d.x); t.y = __builtin_amdgcn_rcpf(d.y);
    f32x2 q = t * 0.5307027145f + (-0.7265760135f); q = q * t + 0.7107068705f; q = q * t + (-0.142248368f); q = q * t + 0.127414796f; q = q * t;
    const f32x2 s = (v * v) * (-0.72134752044f);
    f32x2 e; e.x = __builtin_amdgcn_exp2f(s.x); e.y = __builtin_amdgcn_exp2f(s.y);
    const f32x2 m = v * (q * e), r = v - m;
    f32x2 o; o.x = v.x < 0.f ? m.x : r.x; o.y = v.y < 0.f ? m.y : r.y; return o;
}


typedef unsigned u32x2 __attribute__((ext_vector_type(2)));
__device__ __forceinline__ float row_rstd(const float* ssp, int row, int fq) {
    const f32x4 p = *(const f32x4*)(ssp + (size_t)row * 16 + 4 * fq); float s = (p[0] + p[1]) + (p[2] + p[3]);
    s += __shfl_xor(s, 16); s += __shfl_xor(s, 32); return __builtin_amdgcn_rsqf(s * (1.f / 1024.f) + 1e-6f); }
struct EpiScaleBf16 {
    static constexpr bool PERM = true, AFTER_DRAIN = false;
    bf16_t* O; int ldc; const float* ssp;
    __device__ __forceinline__ void operator()(const f32x4 (&acc)[2][2][4][2], const Unit& u, int wr, int wc, int fr, int fq) const {
        const int row0 = u.pm * BM + wr * 64 + fr, col0 = u.pn * BM + wc * 32 + 8 * fq;
#pragma unroll
        for (int ai = 0; ai < 2; ++ai)
#pragma unroll
            for (int m = 0; m < 4; ++m) { const int row = row0 + ai * HALF + m * 16; const float s = row_rstd(ssp, row, fq); bf16_t* rowp = O + (size_t)row * ldc + col0;
#pragma unroll
                for (int bj = 0; bj < 2; ++bj) { const f32x4 v0 = acc[ai][bj][m][0] * s, v1 = acc[ai][bj][m][1] * s;
                    u32x4 w; w.x = cvt_pk_bf16(v0[0], v0[1]); w.y = cvt_pk_bf16(v0[2], v0[3]); w.z = cvt_pk_bf16(v1[0], v1[1]); w.w = cvt_pk_bf16(v1[2], v1[3]);
                    *(u32x4*)(rowp + bj * HALF) = w; } }
    }
};
struct EpiResid {
    static constexpr bool PERM = false, AFTER_DRAIN = false;
    bf16_t* XB; int ldc; float* ssp;
    __device__ __forceinline__ void operator()(const f32x4 (&acc)[2][2][4][2], const Unit& u, int wr, int wc, int fr, int fq) const {
        const int row0 = u.pm * BM + wr * 64 + fr, col0 = u.pn * BM + wc * 32 + 4 * fq;
#pragma unroll
        for (int ai = 0; ai < 2; ++ai)
#pragma unroll
            for (int m = 0; m < 4; ++m) { const int row = row0 + ai * HALF + m * 16; const size_t off = (size_t)row * ldc + col0; float q = 0.f;
#pragma unroll
                for (int bj = 0; bj < 2; ++bj)
#pragma unroll
                    for (int n = 0; n < 2; ++n) { u32x2* p = (u32x2*)(XB + off + bj * HALF + n * 16); const u32x2 o = *p;
                        const float v0 = __uint_as_float(o.x << 16) + acc[ai][bj][m][n][0], v1 = __uint_as_float(o.x & 0xffff0000u) + acc[ai][bj][m][n][1], v2 = __uint_as_float(o.y << 16) + acc[ai][bj][m][n][2], v3 = __uint_as_float(o.y & 0xffff0000u) + acc[ai][bj][m][n][3];
                        u32x2 w; w.x = cvt_pk_bf16(v0, v1); w.y = cvt_pk_bf16(v2, v3); *p = w;
                        const float r0 = __uint_as_float(w.x << 16), r1 = __uint_as_float(w.x & 0xffff0000u), r2 = __uint_as_float(w.y << 16), r3 = __uint_as_float(w.y & 0xffff0000u);
                        q += (r0 * r0 + r1 * r1) + (r2 * r2 + r3 * r3); }
                q += __shfl_xor(q, 16); q += __shfl_xor(q, 32);
                if (fq == 0) ssp[(size_t)row * 16 + u.pn * 4 + wc] = q; }
    }
};

__device__ __forceinline__ float dpp_ror1(float x) { return __builtin_bit_cast(float, __builtin_amdgcn_mov_dpp(__builtin_bit_cast(int, x), 0x121, 0xf, 0xf, true)); }
__device__ __forceinline__ float gelu_tanh_f(float x) { const float u2 = x * (2.302208198f + 0.1029432397f * x * x);
    return x * __builtin_amdgcn_rcpf(1.f + __builtin_amdgcn_exp2f(-u2)); }
struct EpiFfnUp {
    static constexpr bool PERM = true, AFTER_DRAIN = false, PERMA = true;
    bf16_t* ACT; const float* ssp; const float* cw; const float* cb; float* PRE; float* RAW; PG8_LAS float* halo; int nact  , nup  ;
    __device__ __forceinline__ void operator()(f32x4 (&acc)[2][2][4][2], const Unit& u, int wr, int wc, int fr_, int fq_) const {
        int fr = fr_, fq = fq_; asm volatile("" : "+v"(fr), "+v"(fq));
        const int row0 = u.pm * BM + wr * 64 + 4 * fr;
        const int jt = wc * 32 + 8 * fq;
#pragma unroll
        for (int ai = 0; ai < 2; ++ai)
#pragma unroll
            for (int m = 0; m < 4; ++m) { const float s = row_rstd(ssp, row0 + ai * HALF + m, fq);
#pragma unroll
                for (int bj = 0; bj < 2; ++bj)
#pragma unroll
                    for (int n = 0; n < 2; ++n) acc[ai][bj][m][n] = acc[ai][bj][m][n] * s; }
        if (fr == 15) {
#pragma unroll
            for (int ai = 0; ai < 2; ++ai) { const int B = 2 * ai + wr;
#pragma unroll
                for (int rr = 0; rr < 2; ++rr)
#pragma unroll
                    for (int bj = 0; bj < 2; ++bj)
#pragma unroll
                        for (int n = 0; n < 2; ++n) { *(PG8_LAS f32x4*)(halo + ((B * 2 + rr) * 256 + bj * HALF + jt + 4 * n)) = acc[ai][bj][2 + rr][n];
                            if (B == 3) *(f32x4*)(RAW + (size_t)(u.pm * 2 + rr) * nup + bj * nact + u.pn * HALF + jt + 4 * n) = acc[ai][bj][2 + rr][n]; } }
        }
        asm volatile("s_waitcnt lgkmcnt(0)" ::: "memory"); __builtin_amdgcn_s_barrier(); asm volatile("" ::: "memory");
        typedef float f32x2e __attribute__((ext_vector_type(2)));
#pragma unroll
        for (int n = 0; n < 2; ++n) {
            unsigned pk0[2][4];
#pragma unroll
            for (int ch = 0; ch < 2; ++ch) { const int j = u.pn * HALF + jt + 4 * n + 2 * ch;
                asm volatile("" ::: "memory"); __builtin_amdgcn_sched_barrier(0);
                const f32x2e w0v = *(const f32x2e*)(cw + j), w1v = *(const f32x2e*)(cw + nup + j), w2v = *(const f32x2e*)(cw + 2 * nup + j), bv = *(const f32x2e*)(cb + j);
                const f32x2e w0g = *(const f32x2e*)(cw + nact + j), w1g = *(const f32x2e*)(cw + nup + nact + j), w2g = *(const f32x2e*)(cw + 2 * nup + nact + j), bg = *(const f32x2e*)(cb + nact + j);
#pragma unroll
                for (int ai = 0; ai < 2; ++ai) { const int B = 2 * ai + wr;
                    f32x2e hv0 = {0.f, 0.f}, hv1 = hv0, hg0 = hv0, hg1 = hv0;
                    if (B > 0) { const int hc = jt + 4 * n + 2 * ch;
                        hv0 = *(const PG8_LAS f32x2e*)(halo + (((B - 1) * 2 + 0) * 256 + hc)); hv1 = *(const PG8_LAS f32x2e*)(halo + (((B - 1) * 2 + 1) * 256 + hc));
                        hg0 = *(const PG8_LAS f32x2e*)(halo + (((B - 1) * 2 + 0) * 256 + HALF + hc)); hg1 = *(const PG8_LAS f32x2e*)(halo + (((B - 1) * 2 + 1) * 256 + HALF + hc)); }
                    float yv[4][2], yg[4][2];
#pragma unroll
                    for (int k = 0; k < 2; ++k) { const int e = 2 * ch + k;
                        const float xv0 = acc[ai][0][0][n][e], xv1 = acc[ai][0][1][n][e], xv2 = acc[ai][0][2][n][e], xv3 = acc[ai][0][3][n][e];
                        const float xg0 = acc[ai][1][0][n][e], xg1 = acc[ai][1][1][n][e], xg2 = acc[ai][1][2][n][e], xg3 = acc[ai][1][3][n][e];
                        float rv3 = dpp_ror1(xv3), rv2 = dpp_ror1(xv2), rg3 = dpp_ror1(xg3), rg2 = dpp_ror1(xg2);
                        asm volatile("" : "+v"(rv3), "+v"(rv2), "+v"(rg3), "+v"(rg2));
                        const float sv3 = (fr == 0) ? hv1[k] : rv3, sv2 = (fr == 0) ? hv0[k] : rv2;
                        const float sg3 = (fr == 0) ? hg1[k] : rg3, sg2 = (fr == 0) ? hg0[k] : rg2;
                        yv[0][k] = bv[k] + w2v[k] * xv0 + w1v[k] * sv3 + w0v[k] * sv2; yv[1][k] = bv[k] + w2v[k] * xv1 + w1v[k] * xv0 + w0v[k] * sv3;
                        yv[2][k] = bv[k] + w2v[k] * xv2 + w1v[k] * xv1 + w0v[k] * xv0; yv[3][k] = bv[k] + w2v[k] * xv3 + w1v[k] * xv2 + w0v[k] * xv1;
                        yg[0][k] = bg[k] + w2g[k] * xg0 + w1g[k] * sg3 + w0g[k] * sg2; yg[1][k] = bg[k] + w2g[k] * xg1 + w1g[k] * xg0 + w0g[k] * sg3;
                        yg[2][k] = bg[k] + w2g[k] * xg2 + w1g[k] * xg1 + w0g[k] * xg0; yg[3][k] = bg[k] + w2g[k] * xg3 + w1g[k] * xg2 + w0g[k] * xg1; }
                    if (B == 0 && fr == 0) {
#pragma unroll
                        for (int m = 0; m < 2; ++m) { float* pp = PRE + (size_t)(u.pm * 2 + m) * nup + j; *(f32x2e*)pp = (f32x2e){yv[m][0], yv[m][1]}; *(f32x2e*)(pp + nact) = (f32x2e){yg[m][0], yg[m][1]}; } }
#pragma unroll
                    for (int m = 0; m < 4; ++m) { const unsigned w = cvt_pk_bf16(gelu_tanh_f(yg[m][0]) * yv[m][0], gelu_tanh_f(yg[m][1]) * yv[m][1]);
                        if (ch == 0) pk0[ai][m] = w;
                        else { u32x2 st; st.x = pk0[ai][m]; st.y = w; *(u32x2*)(ACT + (size_t)(row0 + ai * HALF + m) * nact + u.pn * HALF + jt + 4 * n) = st; } }
                }
            }
        }
    }
};
template <class E, class = void> struct pg8_has_perma { static constexpr bool v = false; };
template <class E> struct pg8_has_perma<E, decltype((void)E::PERMA)> { static constexpr bool v = E::PERMA; };
template <class E> __host__ __device__ constexpr bool pg8_perma() { return pg8_has_perma<E>::v; }
template <class Epi, class Sched, bool ALIGN_EPI = false, bool SP2 = false>
__device__ __forceinline__ void gemm_phase(PG8_LAS unsigned char* lds, const Gemm g, const Sched& S, const Epi& E, int tid_in) {
    int tid_l = tid_in; asm volatile("" : "+v"(tid_l));
    const int tid = tid_l, wid = __builtin_amdgcn_readfirstlane(tid >> 6), lane = tid & 63, wr = wid >> 2, wc = wid & 3, fr = lane & 15, fq = lane >> 4;
    const int K = g.K, nt = K / BK;
    unsigned voffA[2], voffB[2];
#pragma unroll
    for (int i = 0; i < 2; ++i) { int R, C; stage_rc(tid * 16 + i * 8192, R, C); const int Rb = Epi::PERM ? ((R & ~31) + perm32(R & 31)) : R;
        const int Ra = pg8_perma<Epi>() ? ((R & 64) | (4 * (R & 15) + ((R >> 4) & 3))) : R;
        voffA[i] = (unsigned)(Ra * K + C) * 2u; voffB[i] = (unsigned)(Rb * K + C) * 2u; }
    const size_t kstep = (size_t)(BK * 2);
    const size_t hstep = (size_t)HALF * K * 2;
    const size_t tstep = 2 * hstep;
    const unsigned ldsw = (unsigned)wid * 1024u;
    const int aoff = lds_byte(wr * 64 + fr, fq * 8), boff = lds_byte(wc * 32 + fr, fq * 8);
#define PG8_SA(b, h) (((b) * 2 + (h)) * HTB)
#define PG8_SB(b, h) ((4 + (b) * 2 + (h)) * HTB)
#define PG8_STAGE(bufoff, gbase, voff) do { _Pragma("unroll") for (int _i = 0; _i < 2; ++_i) \
        __builtin_amdgcn_global_load_lds((const unsigned*)((const char*)(gbase) + (voff)[_i]), (PG8_LAS unsigned*)(lds + (bufoff) + ldsw + _i * 8192), 16, 0, 0); } while (0)
#define PG8_LDA(dst, b, h) do { _Pragma("unroll") for (int m = 0; m < 4; ++m) _Pragma("unroll") for (int k = 0; k < 2; ++k) dst[m][k] = *(const PG8_LAS bf16x8*)(lds + PG8_SA(b, h) + aoff + m * 2048 + k * 1024); } while (0)
#define PG8_LDB(dst, b, h) do { _Pragma("unroll") for (int n = 0; n < 2; ++n) _Pragma("unroll") for (int k = 0; k < 2; ++k) dst[n][k] = *(const PG8_LAS bf16x8*)(lds + PG8_SB(b, h) + boff + n * 2048 + k * 1024); } while (0)
#define PG8_MMA(ai, bj, At, Bt) do { __builtin_amdgcn_s_setprio(1); _Pragma("unroll") for (int m = 0; m < 4; ++m) _Pragma("unroll") for (int n = 0; n < 2; ++n) _Pragma("unroll") for (int k = 0; k < 2; ++k) \
        acc[ai][bj][m][n] = __builtin_amdgcn_mfma_f32_16x16x32_bf16(Bt[n][k], At[m][k], acc[ai][bj][m][n], 0, 0, 0); __builtin_amdgcn_s_setprio(0); } while (0)
#define PG8_WAIT_V(n) asm volatile("s_waitcnt vmcnt(" #n ")" ::: "memory")
#define PG8_WAIT_L(n) asm volatile("s_waitcnt lgkmcnt(" #n ")" ::: "memory")
#define PG8_BAR __builtin_amdgcn_s_barrier()
#define PG8_SCHED __builtin_amdgcn_sched_barrier(0)
    Unit cur, nxt; int ui = 0;
    if (!S.next(0, cur)) return;
    f32x4 acc[2][2][4][2];
#pragma unroll
    for (int a = 0; a < 2; ++a)
#pragma unroll
        for (int b = 0; b < 2; ++b)
#pragma unroll
            for (int m = 0; m < 4; ++m)
#pragma unroll
                for (int n = 0; n < 2; ++n) acc[a][b][m][n] = (f32x4){0.f, 0.f, 0.f, 0.f};
    bf16x8 At[4][2], B0[2][2], B1[2][2];
    const char* cA = (const char*)g.A + (size_t)cur.pm * tstep; const char* cB = (const char*)g.Bt + (size_t)cur.pn * tstep;
    S.a_ready(cur);
    if constexpr (SP2) {
        PG8_STAGE(PG8_SB(0, 0), cB, voffB); PG8_STAGE(PG8_SB(0, 1), cB + hstep, voffB); PG8_STAGE(PG8_SA(0, 0), cA, voffA); PG8_STAGE(PG8_SA(0, 1), cA + hstep, voffA);
        if (wr == 1) PG8_BAR;
        PG8_WAIT_V(2); PG8_BAR;
        PG8_STAGE(PG8_SB(1, 0), cB + kstep, voffB); PG8_STAGE(PG8_SA(1, 0), cA + kstep, voffA); PG8_STAGE(PG8_SB(1, 1), cB + hstep + kstep, voffB);
        PG8_WAIT_V(6); PG8_BAR;
    } else {
        PG8_STAGE(PG8_SB(0, 0), cB, voffB); PG8_STAGE(PG8_SA(0, 0), cA, voffA); PG8_STAGE(PG8_SB(0, 1), cB + hstep, voffB); PG8_STAGE(PG8_SA(0, 1), cA + hstep, voffA);
        if (wr == 1) PG8_BAR;
        PG8_WAIT_V(4); PG8_BAR;
        PG8_STAGE(PG8_SB(1, 0), cB + kstep, voffB); PG8_STAGE(PG8_SA(1, 0), cA + kstep, voffA); PG8_STAGE(PG8_SB(1, 1), cB + hstep + kstep, voffB);
        PG8_WAIT_V(6); PG8_BAR;
    }
    for (;;) {
        const bool has_next = S.next(ui + 1, nxt);
        const char* nA = has_next ? (const char*)g.A + (size_t)nxt.pm * tstep : cA; const char* nB = has_next ? (const char*)g.Bt + (size_t)nxt.pn * tstep : cB;
        for (int t = 0; t < nt; t += 2) {
            const bool last = (t == nt - 2);
            const char* a1 = cA + (size_t)(t + 1) * kstep;
            const char* a2 = last ? nA : cA + (size_t)(t + 2) * kstep; const char* b2 = last ? nB : cB + (size_t)(t + 2) * kstep;
            const char* a3 = a2 + kstep; const char* b3 = b2 + kstep;
            if (last && has_next) S.a_ready(nxt);
            if constexpr (SP2) {
            PG8_LDB(B0, 0, 0); PG8_LDB(B1, 0, 1); PG8_SCHED; PG8_LDA(At, 0, 0); PG8_STAGE(PG8_SA(1, 1), a1 + hstep, voffA);
            PG8_WAIT_V(8); PG8_WAIT_L(0); PG8_BAR; PG8_MMA(0, 0, At, B0); PG8_MMA(0, 1, At, B1); PG8_BAR; PG8_SCHED;
            PG8_LDA(At, 0, 1); PG8_STAGE(PG8_SB(0, 0), b2, voffB); PG8_STAGE(PG8_SB(0, 1), b2 + hstep, voffB); PG8_STAGE(PG8_SA(0, 0), a2, voffA);
            PG8_WAIT_V(8); PG8_WAIT_L(0); PG8_BAR; PG8_MMA(1, 0, At, B0); PG8_MMA(1, 1, At, B1); PG8_BAR; PG8_SCHED;
            PG8_LDB(B0, 1, 0); PG8_LDB(B1, 1, 1); PG8_SCHED; PG8_LDA(At, 1, 0); PG8_STAGE(PG8_SA(0, 1), a2 + hstep, voffA);
            PG8_WAIT_V(8); PG8_WAIT_L(0); PG8_BAR; PG8_MMA(0, 0, At, B0); PG8_MMA(0, 1, At, B1); PG8_BAR; PG8_SCHED;
            PG8_LDA(At, 1, 1); PG8_STAGE(PG8_SB(1, 0), b3, voffB); PG8_STAGE(PG8_SB(1, 1), b3 + hstep, voffB); PG8_STAGE(PG8_SA(1, 0), a3, voffA);
            PG8_WAIT_V(8); PG8_WAIT_L(0); PG8_BAR; PG8_MMA(1, 0, At, B0); PG8_MMA(1, 1, At, B1); PG8_BAR; PG8_SCHED;
            } else {
            PG8_LDB(B0, 0, 0); PG8_SCHED; PG8_LDA(At, 0, 0); PG8_STAGE(PG8_SA(1, 1), a1 + hstep, voffA);
            PG8_WAIT_L(8); PG8_BAR; PG8_WAIT_L(0); PG8_MMA(0, 0, At, B0); PG8_BAR; PG8_SCHED;
            PG8_LDB(B1, 0, 1); PG8_STAGE(PG8_SB(0, 0), b2, voffB);
            PG8_BAR; PG8_WAIT_L(0); PG8_MMA(0, 1, At, B1); PG8_BAR;
            PG8_LDA(At, 0, 1); PG8_STAGE(PG8_SA(0, 0), a2, voffA);
            PG8_BAR; PG8_WAIT_L(0); PG8_MMA(1, 0, At, B0); PG8_BAR; PG8_SCHED;
            PG8_STAGE(PG8_SB(0, 1), b2 + hstep, voffB);
            PG8_WAIT_V(6); PG8_BAR; PG8_MMA(1, 1, At, B1); PG8_BAR;
            PG8_LDB(B0, 1, 0); PG8_SCHED; PG8_LDA(At, 1, 0); PG8_STAGE(PG8_SA(0, 1), a2 + hstep, voffA);
            PG8_WAIT_L(8); PG8_BAR; PG8_WAIT_L(0); PG8_MMA(0, 0, At, B0); PG8_BAR; PG8_SCHED;
            PG8_LDB(B1, 1, 1); PG8_STAGE(PG8_SB(1, 0), b3, voffB);
            PG8_BAR; PG8_WAIT_L(0); PG8_MMA(0, 1, At, B1); PG8_BAR;
            PG8_LDA(At, 1, 1); PG8_STAGE(PG8_SA(1, 0), a3, voffA);
            PG8_BAR; PG8_WAIT_L(0); PG8_MMA(1, 0, At, B0); PG8_BAR; PG8_SCHED;
            PG8_STAGE(PG8_SB(1, 1), b3 + hstep, voffB);
            PG8_WAIT_V(6); PG8_BAR; PG8_MMA(1, 1, At, B1); PG8_BAR;
            }
        }
        if constexpr (ALIGN_EPI) { if (wr == 0) PG8_BAR; }
        if constexpr (!Epi::AFTER_DRAIN) { E(acc, cur, wr, wc, fr, fq); S.done(cur); }
        if (!has_next) break;
#pragma unroll
        for (int a = 0; a < 2; ++a)
#pragma unroll
            for (int b = 0; b < 2; ++b)
#pragma unroll
                for (int m = 0; m < 4; ++m)
#pragma unroll
                    for (int n = 0; n < 2; ++n) acc[a][b][m][n] = (f32x4){0.f, 0.f, 0.f, 0.f};
        cur = nxt; cA = nA; cB = nB; ++ui;
        if constexpr (ALIGN_EPI) { if (wr == 1) PG8_BAR; }
    }
    PG8_WAIT_V(0);
    if constexpr (!ALIGN_EPI) { if (wr == 0) PG8_BAR; }
    PG8_BAR;
    if constexpr (Epi::AFTER_DRAIN) { E.fused(acc, cur, wr, wc, fr, fq, lds, wid, lane); S.done(cur); }
#undef PG8_SA
#undef PG8_SB
#undef PG8_STAGE
#undef PG8_LDA
#undef PG8_LDB
#undef PG8_MMA
#undef PG8_WAIT_V
#undef PG8_WAIT_L
#undef PG8_BAR
#undef PG8_SCHED
}
}

#ifndef MK_ONE_LAUNCH
#define MK_ONE_LAUNCH 1
#endif
#define LAS __attribute__((address_space(3)))
typedef unsigned short bf16;
typedef float f32x4 __attribute__((ext_vector_type(4)));
typedef unsigned u32x4w __attribute__((ext_vector_type(4)));

constexpr int DM = 1024, NBATCH = 16, SEQ = 2048, M = NBATCH * SEQ, DEPTH = 4;
constexpr int NPROJ = 3072, FFN = 2816, NUP = 5632, INC = 2832;
constexpr int PQ = 0, PK = 192, PV = 384, PR = 768, PG = 1152, PBG = 1344, PBI = 1600, PCQ = 1856, PCK = 2240, PCV = 2624;
constexpr int OA = 0, OB = 384, OC = 640;
constexpr float EPS = 1e-6f;

constexpr size_t MiB = 1u << 20;
constexpr size_t WS_CTL = 0, CTL_ZERO_BYTES = 163840;
constexpr size_t WS_COS = 1 * MiB, WS_SIN = WS_COS + 65536;
constexpr size_t WS_W0 = 2 * MiB, WS_W1 = 480 * MiB;
constexpr size_t WO_IN = 0, WO_OUT = 6 * MiB, WO_UP = 8 * MiB, WO_DN = 19 * MiB, WO_LRUW = 24 * MiB + 512 * 1024, WO_LRUSP = WO_LRUW + 65536, WSET_BYTES = 25 * MiB;
constexpr size_t WS_XB = 28 * MiB, WS_PROJ = 92 * MiB, WS_ACT = 92 * MiB, WS_MIX = 284 * MiB;
constexpr size_t WS_SS = 28 * MiB;
constexpr size_t WS_PRE = 348 * MiB, WS_RAW = 354 * MiB;
constexpr size_t WS_OP = 348 * MiB, WS_LSE = 420 * MiB, WS_HIN = 423 * MiB, WS_SSP = 426 * MiB;
constexpr size_t WS_US = 436 * MiB, WS_DB = 472 * MiB, WS_PB = 473 * MiB, WS_QB = 475 * MiB, WS_END = 512 * MiB;
static_assert(WS_W0 + WSET_BYTES <= WS_XB && WS_W1 + WSET_BYTES <= WS_END && WO_DN + (size_t)DM * FFN * 2 <= WO_LRUW && WS_OP + (size_t)3 * M * 384 * 2 <= WS_LSE && WS_US + (size_t)4096 * 96 * 48 * 2 <= WS_DB, "ws map");
constexpr int CW_BAR = 4096;

constexpr int RING_BYTES = 131072, MISC_OFF = RING_BYTES + 320, HALO_OFF = RING_BYTES + 1024, LDS_BYTES = 147456;

constexpr int PPL = 7;
constexpr int P_PRO = 0, P_FIN = 1 + DEPTH * PPL, NPH = P_FIN + 1;
enum { L_INPROJ = 0, L_MA, L_MB, L_MC, L_OUTPROJ, L_UP, L_DOWN };
static_assert(L_DOWN == PPL - 1, "phase ids");

#define XB_TMO      128
#define XB_XCNT(j)  (256  + 64 * (j))
#define XB_XSUB(j)  (1280 + 64 * (j))
#define XB_XGEN(j)  (2304 + 64 * (j))
#define XB_TOP      3328
#define XB_TOPGEN   3392
#define XCD_BAR_WORDS 3456
#define XB_SPIN_CAP (1u << 18)

__device__ __forceinline__ unsigned xb_ld(unsigned* p)              { return __hip_atomic_load(p, __ATOMIC_RELAXED, __HIP_MEMORY_SCOPE_AGENT); }
__device__ __forceinline__ unsigned xb_add(unsigned* p, unsigned v) { return __hip_atomic_fetch_add(p, v, __ATOMIC_RELAXED, __HIP_MEMORY_SCOPE_AGENT); }
__device__ __forceinline__ unsigned xb_xcc_id() { return (unsigned)__builtin_amdgcn_s_getreg((3 << 11) | 20) & 0xFu; }
#define XB_SPIN(cond, bar) do { unsigned _sp = 0; while (cond) { __builtin_amdgcn_s_sleep(1); \
    if ((++_sp & 255u) == 0u) { if (xb_ld(&(bar)[XB_TMO])) break; if (_sp > XB_SPIN_CAP) { atomicAdd(&(bar)[XB_TMO], 1u); break; } } } } while (0)

struct XcdBarrier {
    unsigned* bar; unsigned x, ng;
    volatile LAS unsigned* st;
};

__device__ __forceinline__ XcdBarrier xcd_barrier_post(unsigned* bar, volatile LAS unsigned* st, unsigned ng) {
    XcdBarrier b; b.bar = bar; b.x = xb_xcc_id(); b.st = st; b.ng = ng;
    if (threadIdx.x == 0) (void)xb_add(&bar[XB_XCNT(b.x)], 1u);
    return b;
}
__device__ __forceinline__ void xcd_barrier_complete(unsigned* bar, unsigned x, unsigned& nloc, unsigned& nx, const unsigned G  ) {
    unsigned sum, cnt, mine, sp = 0u;
    for (;;) {
        sum = 0u; cnt = 0u; mine = 0u;
#pragma unroll
        for (unsigned j = 0; j < 16; ++j) { const unsigned c = xb_ld(&bar[XB_XCNT(j)]); sum += c; cnt += (c > 0u) ? 1u : 0u; mine = (j == x) ? c : mine; }
        if (sum == G) break;
        __builtin_amdgcn_s_sleep(1);
        if ((++sp & 255u) == 0u) { if (xb_ld(&bar[XB_TMO])) break; if (sp > XB_SPIN_CAP) { atomicAdd(&bar[XB_TMO], 1u); break; } }
    }
    nloc = mine > 0u ? mine : 1u; nx = cnt > 0u ? cnt : 1u;
}

__device__ __forceinline__ void xcd_barrier(const XcdBarrier& b) {
    asm volatile("s_waitcnt vmcnt(0)" ::: "memory");
    __syncthreads();
    if (threadIdx.x == 0) {
        unsigned* bar = b.bar;
        __builtin_amdgcn_s_waitcnt(0);
        unsigned nloc = b.st[0], nx = b.st[1];
        if (nloc == 0u) { xcd_barrier_complete(bar, b.x, nloc, nx, b.ng); b.st[0] = nloc; b.st[1] = nx; }
        const unsigned old = xb_add(&bar[XB_XSUB(b.x)], 1u);
        const unsigned gen = old / nloc;
        if (old + 1u == (gen + 1u) * nloc) {
            __builtin_amdgcn_fence(__ATOMIC_RELEASE, "agent");
            asm volatile("s_waitcnt vmcnt(0)" ::: "memory");
            const unsigned og = xb_add(&bar[XB_TOP], 1u);
            const unsigned tg = og / nx;
            if (og + 1u == (tg + 1u) * nx) xb_add(&bar[XB_TOPGEN], 1u);
            else XB_SPIN(xb_ld(&bar[XB_TOPGEN]) == tg, bar);
            __builtin_amdgcn_fence(__ATOMIC_ACQUIRE, "agent");
            xb_add(&bar[XB_XGEN(b.x)], 1u);
            asm volatile("s_waitcnt vmcnt(0)" ::: "memory");
        } else {
            XB_SPIN(xb_ld(&bar[XB_XGEN(b.x)]) == gen, bar);
            __builtin_amdgcn_fence(__ATOMIC_ACQUIRE, "agent");
            asm volatile("s_waitcnt vmcnt(0)" ::: "memory");
        }
    }
    __syncthreads();
}


__device__ __forceinline__ float bf2f(bf16 b) { return __uint_as_float((unsigned)b << 16); }
__device__ __forceinline__ bf16 f2bf(float f) { const unsigned u = __float_as_uint(f); return (bf16)((u + 0x7fffu + ((u >> 16) & 1u)) >> 16); }
__device__ __forceinline__ unsigned pk2(float lo, float hi) { return (unsigned)f2bf(lo) | ((unsigned)f2bf(hi) << 16); }
__device__ __forceinline__ float wave_sum(float v) {
#pragma unroll
    for (int o = 1; o < 64; o <<= 1) v += __shfl_xor(v, o);
    return v;
}
__device__ __forceinline__ float sigmoidf_(float x) { return 1.f / (1.f + __expf(-x)); }
__device__ __forceinline__ float gelu_tanh(float x) { const float u = 0.7978845608028654f * (x + 0.044715f * x * x * x); const float t = 1.f - 2.f / (1.f + __expf(2.f * u)); return 0.5f * x * (1.f + t); }
__device__ __forceinline__ float softplusf_(float x) { return fmaxf(x, 0.f) + log1pf(__expf(-fabsf(x))); }

__device__ __forceinline__ void wt_tile(const float* __restrict__ W, int K, int Nsrc, bf16* __restrict__ WT, LAS unsigned char* scr, int item, int nblk, int lane_, const float* __restrict__ gain, int mode) {
    const int kb = item / nblk, nb = item % nblk, k0 = 32 * kb, n0 = 256 * nb, n4 = n0 + 4 * lane_;
    int src = n4; float sc = 1.f; bool zero = false;
    if (mode == 1) { if (n4 >= 3008) zero = true; else if (n4 >= PG && n4 < PBG) zero = true  ; else { src = (n4 < PG) ? n4 : n4 - 176; sc = (n4 < PK) ? 0.14433756729740643f : ((n4 >= PCQ && n4 < PCK) ? 0.18033688011112042f : 1.f); } }
    else if (mode == 2) src = ((n4 >> 7) & 1) * FFN + (n4 >> 8) * 128 + (n4 & 127);
#pragma unroll
    for (int kg = 0; kg < 4; kg += 2) { f32x4 v[16];
#pragma unroll
        for (int kk = 0; kk < 16; ++kk) v[kk] = zero ? (f32x4){0.f, 0.f, 0.f, 0.f} : *(const f32x4*)(W + (size_t)(k0 + 8 * kg + kk) * Nsrc + src);
#pragma unroll
        for (int g2 = 0; g2 < 2; ++g2) { float gk[8];
#pragma unroll
            for (int kk = 0; kk < 8; ++kk) gk[kk] = gain ? gain[k0 + 8 * (kg + g2) + kk] * sc : sc;
#pragma unroll
            for (int j = 0; j < 4; ++j) { u32x4w w; w.x = pk2(v[8 * g2 + 0][j] * gk[0], v[8 * g2 + 1][j] * gk[1]); w.y = pk2(v[8 * g2 + 2][j] * gk[2], v[8 * g2 + 3][j] * gk[3]);
                w.z = pk2(v[8 * g2 + 4][j] * gk[4], v[8 * g2 + 5][j] * gk[5]); w.w = pk2(v[8 * g2 + 6][j] * gk[6], v[8 * g2 + 7][j] * gk[7]);
                *(LAS u32x4w*)(scr + (4 * lane_ + j) * 64 + (kg + g2) * 16) = w; } } }
    asm volatile("s_waitcnt lgkmcnt(0)" ::: "memory");
#pragma unroll
    for (int c = 0; c < 16; ++c) { const int id = lane_ + 64 * c, row = id >> 2, part = id & 3, n = n0 + row;
        const u32x4w w = *(const LAS u32x4w*)(scr + row * 64 + part * 16);
        if (!(mode == 1 && n >= PG && n < PBG)) *(u32x4w*)(WT + (size_t)n * K + k0 + 8 * part) = w; }
    asm volatile("s_waitcnt lgkmcnt(0)" ::: "memory");
}
__device__ __forceinline__ void convert_layer_weights(int l, unsigned char* ws, int gw_, int ngw_, int lane_, LAS unsigned char* scr, int gtid_, int gsz_, const float* norm_mix_, const float* w_in_, const float* gla_w_gate_, const float* w_out_, const float* norm_ffn_, const float* ffn_w_up_,
                                                      const float* ffn_w_down_, const float* lru_w_a_, const float* lru_w_x_, const float* lru_lambda_) {
    bf16* Win_t = (bf16*)(ws + WO_IN); bf16* Wout_t = (bf16*)(ws + WO_OUT); bf16* Wup_t = (bf16*)(ws + WO_UP); bf16* Wdn_t = (bf16*)(ws + WO_DN); uint4* LRUW = (uint4*)(ws + WO_LRUW); float* LRUSP = (float*)(ws + WO_LRUSP);
    constexpr int I_IN = (DM / 32) * (NPROJ / 256), I_OUT = (DM / 32) * (DM / 256), I_UP = (DM / 32) * (NUP / 256), I_DN = (FFN / 32) * (DM / 256);
    for (int it = gw_; it < I_IN + I_OUT + I_UP + I_DN; it += ngw_) { int r = it;
        if (r < I_IN) { wt_tile(w_in_ + (size_t)l * DM * INC, DM, INC, Win_t, scr, r, NPROJ / 256, lane_, norm_mix_ + l * DM, 1); continue; } r -= I_IN;
        if (r < I_OUT) { wt_tile(w_out_ + (size_t)l * DM * DM, DM, DM, Wout_t, scr, r, DM / 256, lane_, nullptr, 0); continue; } r -= I_OUT;
        if (r < I_UP) { wt_tile(ffn_w_up_ + (size_t)l * DM * NUP, DM, NUP, Wup_t, scr, r, NUP / 256, lane_, norm_ffn_ + l * DM, 2); continue; } r -= I_UP;
        wt_tile(ffn_w_down_ + (size_t)l * FFN * DM, FFN, DM, Wdn_t, scr, r, DM / 256, lane_, nullptr, 0); }
    { const float* wl = w_in_ + (size_t)l * DM * INC; const float* gm = norm_mix_ + l * DM; const float* wg = gla_w_gate_ + (size_t)l * 16 * 192;
        for (int it = gtid_; it < 192 * (DM / 8); it += gsz_) { const int c = it % 192, k0 = (it / 192) * 8; float v[8];
#pragma unroll
            for (int kk = 0; kk < 8; ++kk) { const float* wr_ = wl + (size_t)(k0 + kk) * INC + 1152; float s = 0.f;
#pragma unroll
                for (int j = 0; j < 16; ++j) s += wr_[j] * wg[j * 192 + c];
                v[kk] = s * gm[k0 + kk]; }
            *(uint4*)(Win_t + (size_t)(PG + c) * DM + k0) = make_uint4(pk2(v[0], v[1]), pk2(v[2], v[3]), pk2(v[4], v[5]), pk2(v[6], v[7])); } }
    for (int it = gtid_; it < 2 * 8 * 2 * 64; it += gsz_) { const int ln_ = it & 63, hf = (it >> 6) & 1, n = (it >> 7) & 7, g = it >> 10, fr = ln_ & 15, q = ln_ >> 4;
        const float* Wg = (g ? lru_w_x_ : lru_w_a_) + (size_t)(l * 8 + n) * 1024; float v[8];
#pragma unroll
        for (int e = 0; e < 8; ++e) v[e] = Wg[(8 * q + e) * 32 + 16 * hf + fr];
        LRUW[it] = make_uint4(pk2(v[0], v[1]), pk2(v[2], v[3]), pk2(v[4], v[5]), pk2(v[6], v[7])); }
    for (int c = gtid_; c < 256; c += gsz_) LRUSP[c] = softplusf_(-lru_lambda_[l * 256 + c]);
}


typedef short bf16x8v __attribute__((ext_vector_type(8)));
typedef float f32x16 __attribute__((ext_vector_type(16)));
typedef unsigned u32x4v __attribute__((ext_vector_type(4)));
typedef float f32x2_t __attribute__((ext_vector_type(2)));
typedef __bf16 bf16x2_t __attribute__((ext_vector_type(2)));
__device__ __forceinline__ unsigned cvtpk(float lo, float hi) { f32x2_t v = {lo, hi}; bf16x2_t b = __builtin_convertvector(v, bf16x2_t); return __builtin_bit_cast(unsigned, b); }
__device__ __forceinline__ void unpack8(const uint4 u, float (&f)[8]) {
    f[0] = __uint_as_float(u.x << 16); f[1] = __uint_as_float(u.x & 0xffff0000u); f[2] = __uint_as_float(u.y << 16); f[3] = __uint_as_float(u.y & 0xffff0000u);
    f[4] = __uint_as_float(u.z << 16); f[5] = __uint_as_float(u.z & 0xffff0000u); f[6] = __uint_as_float(u.w << 16); f[7] = __uint_as_float(u.w & 0xffff0000u); }
__device__ __forceinline__ bf16x8v pack8(const float (&f)[8]) {
    u32x4v w; w.x = cvtpk(f[0], f[1]); w.y = cvtpk(f[2], f[3]); w.z = cvtpk(f[4], f[5]); w.w = cvtpk(f[6], f[7]); return __builtin_bit_cast(bf16x8v, w); }
__device__ __forceinline__ bf16x8v pack8v(const f32x16& p, int o) {
    u32x4v w; w.x = cvtpk(p[o + 0], p[o + 1]); w.y = cvtpk(p[o + 2], p[o + 3]); w.z = cvtpk(p[o + 4], p[o + 5]); w.w = cvtpk(p[o + 6], p[o + 7]); return __builtin_bit_cast(bf16x8v, w); }
#define MFMA32(a, b, c) __builtin_amdgcn_mfma_f32_32x32x16_bf16((a), (b), (c), 0, 0, 0)

__device__ __forceinline__ void gla_scan(const uint4 (&gp)[3], const float* __restrict__ bgate  , int hh, int r, float (&bv)[3][8]) {
#pragma unroll
    for (int s = 0; s < 3; ++s) { float x[8]; unpack8(gp[s], x);
#pragma unroll
        for (int e = 0; e < 8; ++e) { const float xx = x[e] + bgate[16 * s + 8 * hh + e]; bv[s][e] = (fminf(xx, 0.f) - __logf(1.f + __expf(-fabsf(xx)))) * 0.0625f; } }
#pragma unroll
    for (int s = 0; s < 3; ++s)
#pragma unroll
        for (int e = 0; e < 8; ++e) { float v = bv[s][e];
            v += __builtin_bit_cast(float, __builtin_amdgcn_mov_dpp(__builtin_bit_cast(int, v), 0x111, 0xf, 0xf, true));
            v += __builtin_bit_cast(float, __builtin_amdgcn_mov_dpp(__builtin_bit_cast(int, v), 0x112, 0xf, 0xf, true));
            v += __builtin_bit_cast(float, __builtin_amdgcn_mov_dpp(__builtin_bit_cast(int, v), 0x114, 0xf, 0xf, true));
            v += __builtin_bit_cast(float, __builtin_amdgcn_mov_dpp(__builtin_bit_cast(int, v), 0x118, 0xf, 0xf, true));
            v += __builtin_bit_cast(float, __builtin_amdgcn_update_dpp(0, __builtin_bit_cast(int, v), 0x142, 0xa, 0xf, false));
            bv[s][e] = v; }
    (void)r;
}
__device__ __forceinline__ void gla_vload(const bf16* __restrict__ vbase  , int hh, unsigned (&w)[3][2][4]) {
#pragma unroll
    for (int dt = 0; dt < 3; ++dt)
#pragma unroll
        for (int sp = 0; sp < 2; ++sp)
#pragma unroll
            for (int j2 = 0; j2 < 4; ++j2) { const int j = 2 * j2; const int t0 = 16 * sp + 8 * (j >> 2) + 4 * hh + (j & 3);
                w[dt][sp][j2] = (unsigned)vbase[(size_t)t0 * NPROJ + 32 * dt] | ((unsigned)vbase[(size_t)(t0 + 1) * NPROJ + 32 * dt] << 16); }
}
__device__ __forceinline__ bf16x8v gla_vf(const unsigned (&w)[4]) { u32x4v v; v.x = w[0]; v.y = w[1]; v.z = w[2]; v.w = w[3]; return __builtin_bit_cast(bf16x8v, v); }
__device__ __forceinline__ void gla_m1_unit(int unit, int l, int lane_, const bf16* __restrict__ PROJ_, const float* __restrict__ gla_b_gate_, bf16* __restrict__ US_, float* __restrict__ DB_) {
    const int n = unit & 63, bh = unit >> 6, h = bh & 3, b = bh >> 2, r = lane_ & 31, hh = lane_ >> 5;
    const size_t row0 = (size_t)b * SEQ + n * 32;
    const bf16* prow = PROJ_ + (row0 + r) * NPROJ;
    uint4 gp[3], gk[3]; unsigned vw[3][2][4];
#pragma unroll
    for (int s = 0; s < 3; ++s) { gp[s] = *(const uint4*)(prow + PG + h * 48 + 16 * s + 8 * hh); gk[s] = *(const uint4*)(prow + PK + h * 48 + 16 * s + 8 * hh); }
    gla_vload(PROJ_ + row0 * NPROJ + PV + h * 96 + r, hh, vw);
    float bv[3][8]; gla_scan(gp, gla_b_gate_ + l * 192 + h * 48, hh, r, bv);
    bf16x8v kd[3];
#pragma unroll
    for (int s = 0; s < 3; ++s) { float x[8]; unpack8(gk[s], x);
#pragma unroll
        for (int e = 0; e < 8; ++e) { const float bl = __shfl(bv[s][e], 31, 32); x[e] *= __expf(bl - bv[s][e]); }
        kd[s] = pack8(x); }
    if (r == 31) {
#pragma unroll
        for (int s = 0; s < 3; ++s)
#pragma unroll
            for (int e = 0; e < 8; ++e) DB_[(size_t)unit * 48 + 16 * s + 8 * hh + e] = __expf(bv[s][e]); }
    bf16x8v I00, I10, I21;
#pragma unroll
    for (int e = 0; e < 8; ++e) { I00[e] = (8 * hh + e == r) ? (short)0x3F80 : (short)0; I10[e] = (16 + 8 * hh + e == r) ? (short)0x3F80 : (short)0; I21[e] = (8 * hh + e == r) ? (short)0x3F80 : (short)0; }
    f32x16 X0, X1;
#pragma unroll
    for (int i = 0; i < 16; ++i) { X0[i] = 0.f; X1[i] = 0.f; }
    X0 = MFMA32(kd[0], I00, X0); X0 = MFMA32(kd[1], I10, X0); X1 = MFMA32(kd[2], I21, X1);
    const bf16x8v xa00 = pack8v(X0, 0), xa01 = pack8v(X0, 8), xa10 = pack8v(X1, 0), xa11 = pack8v(X1, 8);
    bf16* ub = US_ + (size_t)unit * 96 * 48;
#pragma unroll
    for (int dt = 0; dt < 3; ++dt) { const bf16x8v v0 = gla_vf(vw[dt][0]), v1 = gla_vf(vw[dt][1]);
        f32x16 A0, A1;
#pragma unroll
        for (int i = 0; i < 16; ++i) { A0[i] = 0.f; A1[i] = 0.f; }
        A0 = MFMA32(xa00, v0, A0); A0 = MFMA32(xa01, v1, A0); A1 = MFMA32(xa10, v0, A1); A1 = MFMA32(xa11, v1, A1);
        bf16* up = ub + (size_t)(32 * dt + r) * 48;
#pragma unroll
        for (int qd = 0; qd < 4; ++qd) { pg8::u32x2 w; w.x = cvtpk(A0[4 * qd], A0[4 * qd + 1]); w.y = cvtpk(A0[4 * qd + 2], A0[4 * qd + 3]); *(pg8::u32x2*)(up + 8 * qd + 4 * hh) = w; }
#pragma unroll
        for (int qd = 0; qd < 2; ++qd) { pg8::u32x2 w; w.x = cvtpk(A1[4 * qd], A1[4 * qd + 1]); w.y = cvtpk(A1[4 * qd + 2], A1[4 * qd + 3]); *(pg8::u32x2*)(up + 32 + 8 * qd + 4 * hh) = w; }
    }
}
__device__ __forceinline__ void gla_m2_item(int item, const bf16* __restrict__ US_, bf16* __restrict__ SS_, const float* __restrict__ DB_) {
    const int c8 = item % 6, dv = (item / 6) % 96, bh = item / 576;
    float S[8];
#pragma unroll
    for (int e = 0; e < 8; ++e) S[e] = 0.f;
#pragma unroll 16
    for (int n = 0; n < 64; ++n) { const size_t unit = (size_t)bh * 64 + n; const uint4* p = (const uint4*)(US_ + (unit * 96 + dv) * 48 + c8 * 8); uint4* po = (uint4*)(SS_ + (unit * 96 + dv) * 48 + c8 * 8); const float4* dp = (const float4*)(DB_ + unit * 48 + c8 * 8);
        const uint4 u = *p; const float4 d0 = dp[0], d1 = dp[1]; float x[8]; unpack8(u, x);
        *po = make_uint4(cvtpk(S[0], S[1]), cvtpk(S[2], S[3]), cvtpk(S[4], S[5]), cvtpk(S[6], S[7]));
        S[0] = d0.x * S[0] + x[0]; S[1] = d0.y * S[1] + x[1]; S[2] = d0.z * S[2] + x[2]; S[3] = d0.w * S[3] + x[3];
        S[4] = d1.x * S[4] + x[4]; S[5] = d1.y * S[5] + x[5]; S[6] = d1.z * S[6] + x[6]; S[7] = d1.w * S[7] + x[7]; }
}
__device__ __forceinline__ void gla_m3_unit(int unit, int l, int lane_, const bf16* __restrict__ PROJ_, const float* __restrict__ gla_b_gate_, const float* __restrict__ gla_norm_, const bf16* __restrict__ SS_, bf16* __restrict__ MIX_) {
    const int n = unit & 63, bh = unit >> 6, h = bh & 3, b = bh >> 2, r = lane_ & 31, hh = lane_ >> 5;
    const size_t row0 = (size_t)b * SEQ + n * 32;
    const bf16* prow = PROJ_ + (row0 + r) * NPROJ;
    uint4 gp[3], gq[3], gk[3]; unsigned vw[3][2][4]; bf16x8v sf[3][3]; unsigned short rg[16][3];
#pragma unroll
    for (int s = 0; s < 3; ++s) { gp[s] = *(const uint4*)(prow + PG + h * 48 + 16 * s + 8 * hh); gq[s] = *(const uint4*)(prow + PQ + h * 48 + 16 * s + 8 * hh); gk[s] = *(const uint4*)(prow + PK + h * 48 + 16 * s + 8 * hh); }
    gla_vload(PROJ_ + row0 * NPROJ + PV + h * 96 + r, hh, vw);
    const bf16* ub = SS_ + (size_t)unit * 96 * 48;
#pragma unroll
    for (int dt = 0; dt < 3; ++dt)
#pragma unroll
        for (int s = 0; s < 3; ++s) sf[dt][s] = *(const bf16x8v*)(ub + (size_t)(32 * dt + r) * 48 + 16 * s + 8 * hh);
#pragma unroll
    for (int i = 0; i < 16; ++i) { const int ti = (i & 3) + 8 * (i >> 2) + 4 * hh;
#pragma unroll
        for (int dt = 0; dt < 3; ++dt) rg[i][dt] = PROJ_[(row0 + ti) * NPROJ + PR + h * 96 + 32 * dt + r]; }
    float bv[3][8]; gla_scan(gp, gla_b_gate_ + l * 192 + h * 48, hh, r, bv);
    bf16x8v qt[3], kt[3];
#pragma unroll
    for (int s = 0; s < 3; ++s) { float xq[8], xk[8]; unpack8(gq[s], xq); unpack8(gk[s], xk);
#pragma unroll
        for (int e = 0; e < 8; ++e) { const float eb = __expf(bv[s][e]); xq[e] *= eb; xk[e] *= __builtin_amdgcn_rcpf(eb); }
        qt[s] = pack8(xq); kt[s] = pack8(xk); }
    f32x16 P;
#pragma unroll
    for (int i = 0; i < 16; ++i) P[i] = 0.f;
#pragma unroll
    for (int s = 0; s < 3; ++s) P = MFMA32(kt[s], qt[s], P);
#pragma unroll
    for (int i = 0; i < 16; ++i) { const int j = (i & 3) + 8 * (i >> 2) + 4 * hh; if (j > r) P[i] = 0.f; }
    const bf16x8v p0 = pack8v(P, 0), p1 = pack8v(P, 8);
    f32x16 O[3];
#pragma unroll
    for (int dt = 0; dt < 3; ++dt) {
#pragma unroll
        for (int i = 0; i < 16; ++i) O[dt][i] = 0.f;
        O[dt] = MFMA32(p0, gla_vf(vw[dt][0]), O[dt]); O[dt] = MFMA32(p1, gla_vf(vw[dt][1]), O[dt]);
#pragma unroll
        for (int s = 0; s < 3; ++s) O[dt] = MFMA32(qt[s], sf[dt][s], O[dt]);
    }
    const float* gn = gla_norm_ + l * 96; const float g0 = gn[r], g1 = gn[32 + r], g2 = gn[64 + r];
    bf16* mix0 = MIX_ + (row0 + 4 * hh) * DM + OA + h * 96 + r;
#pragma unroll
    for (int i = 0; i < 16; ++i) { float ss = O[0][i] * O[0][i] + O[1][i] * O[1][i] + O[2][i] * O[2][i];
        ss += __builtin_bit_cast(float, __builtin_amdgcn_mov_dpp(__builtin_bit_cast(int, ss), 0x128, 0xf, 0xf, true));
        ss += __builtin_bit_cast(float, __builtin_amdgcn_mov_dpp(__builtin_bit_cast(int, ss), 0x124, 0xf, 0xf, true));
        ss += __builtin_bit_cast(float, __builtin_amdgcn_mov_dpp(__builtin_bit_cast(int, ss), 0x122, 0xf, 0xf, true));
        ss += __builtin_bit_cast(float, __builtin_amdgcn_mov_dpp(__builtin_bit_cast(int, ss), 0x121, 0xf, 0xf, true));
        ss += __shfl_xor(ss, 16);
        const float rs = __builtin_amdgcn_rsqf(ss * (1.f / 96.f) + EPS);
        float ov[3];
#pragma unroll
        for (int dt = 0; dt < 3; ++dt) { const float rr = bf2f(rg[i][dt]); const float gnv = dt == 0 ? g0 : (dt == 1 ? g1 : g2); ov[dt] = O[dt][i] * rs * gnv * rr * __builtin_amdgcn_rcpf(1.f + __expf(-rr)); }
        bf16* mp = mix0 + (size_t)((i & 3) + 8 * (i >> 2)) * DM; const unsigned w01 = cvtpk(ov[0], ov[1]), w2 = cvtpk(ov[2], ov[2]);
        mp[0] = (bf16)w01; mp[32] = (bf16)(w01 >> 16); mp[64] = (bf16)w2; }
}

typedef float f32x4v __attribute__((ext_vector_type(4)));
#define MFMA16(a, b, c) __builtin_amdgcn_mfma_f32_16x16x32_bf16((a), (b), (c), 0, 0, 0)

__device__ __forceinline__ void lru_tile_block(const bf16* PROJ_, size_t row0, int t0, int n, int lane_, const float* cw  , const float* cb, const uint4* lruw, const float* ba, const float* bx, const float* sp,
                                               float (&av)[2][4], float (&uv)[2][4]) {
    const int fr = lane_ & 15, q = lane_ >> 4, t = t0 + fr, cbase = 32 * n + 8 * q;
    float y[8];
    { const float4 b0 = *(const float4*)(cb + cbase), b1 = *(const float4*)(cb + cbase + 4); y[0] = b0.x; y[1] = b0.y; y[2] = b0.z; y[3] = b0.w; y[4] = b1.x; y[5] = b1.y; y[6] = b1.z; y[7] = b1.w; }
#pragma unroll
    for (int k = 0; k < 4; ++k) if (t - 3 + k >= 0) { const uint4 u = *(const uint4*)(PROJ_ + (row0 + fr - 3 + k) * NPROJ + PBI + cbase); float x[8]; unpack8(u, x);
        const float4 w0 = *(const float4*)(cw + k * 256 + cbase), w1 = *(const float4*)(cw + k * 256 + cbase + 4);
        y[0] += w0.x * x[0]; y[1] += w0.y * x[1]; y[2] += w0.z * x[2]; y[3] += w0.w * x[3]; y[4] += w1.x * x[4]; y[5] += w1.y * x[5]; y[6] += w1.z * x[6]; y[7] += w1.w * x[7]; }
    const bf16x8v uA = pack8(y);
#pragma unroll
    for (int hf = 0; hf < 2; ++hf) {
        const bf16x8v Wa = __builtin_bit_cast(bf16x8v, lruw[((0 * 8 + n) * 2 + hf) * 64 + lane_]), Wx = __builtin_bit_cast(bf16x8v, lruw[((1 * 8 + n) * 2 + hf) * 64 + lane_]);
        bf16x8v I;
#pragma unroll
        for (int e = 0; e < 8; ++e) I[e] = (8 * q + e == 16 * hf + fr) ? (short)0x3F80 : (short)0;
        const f32x4v z = {0.f, 0.f, 0.f, 0.f};
        const f32x4v rr = MFMA16(uA, Wa, z), ii = MFMA16(uA, Wx, z), xx = MFMA16(uA, I, z);
        const int c = 32 * n + 16 * hf + fr; const float bac = ba[c], bxc = bx[c], spc = sp[c];
#pragma unroll
        for (int g = 0; g < 4; ++g) { const float r = __builtin_amdgcn_rcpf(1.f + __expf(-(rr[g] + bac))), ig = __builtin_amdgcn_rcpf(1.f + __expf(-(ii[g] + bxc))), la = -8.f * r * spc;
            const float a_ = __expf(la); av[hf][g] = a_; uv[hf][g] = __builtin_amdgcn_sqrtf(fmaxf(1.f - a_ * a_, 0.f)) * ig * xx[g]; }
    }
}
__device__ __forceinline__ void lru_m1_unit(int unit, int l, int lane_, const bf16* PROJ_, const float* lru_conv_w_, const float* lru_conv_b_, const uint4* lruw, const float* lru_b_a_, const float* lru_b_x_, const float* sp, float* PB_, float* QB_) {
    const int tt = unit & 127, b = unit >> 7, fr = lane_ & 15, q = lane_ >> 4;
    const size_t row0 = (size_t)b * SEQ + tt * 16;
#pragma unroll 1
    for (int n = 0; n < 8; ++n) { float av[2][4], uv[2][4];
        lru_tile_block(PROJ_, row0, tt * 16, n, lane_, lru_conv_w_ + l * 1024, lru_conv_b_ + l * 256, lruw, lru_b_a_ + l * 256, lru_b_x_ + l * 256, sp, av, uv);
#pragma unroll
        for (int hf = 0; hf < 2; ++hf) { const float A = av[hf][0] * av[hf][1] * av[hf][2] * av[hf][3], B = ((uv[hf][0] * av[hf][1] + uv[hf][1]) * av[hf][2] + uv[hf][2]) * av[hf][3] + uv[hf][3];
            float At = 1.f, Bt = 0.f;
#pragma unroll
            for (int g = 0; g < 4; ++g) { const float Ag = __shfl(A, fr + 16 * g), Bg = __shfl(B, fr + 16 * g); Bt = Ag * Bt + Bg; At = Ag * At; }
            if (q == 0) { const size_t o = (size_t)unit * 256 + 32 * n + 16 * hf + fr; PB_[o] = At; QB_[o] = Bt; } }
    }
}
__device__ __forceinline__ void lru_m2_item(int item, const float* PB_, const float* QB_, float* HIN_) {
    const int c = item & 255, b = item >> 8; float h = 0.f;
#pragma unroll 32
    for (int tt = 0; tt < 128; ++tt) { const size_t o = ((size_t)b * 128 + tt) * 256 + c; const float p = PB_[o], qv = QB_[o]; HIN_[o] = h; h = p * h + qv; }
}
__device__ __forceinline__ void lru_m3_unit(int unit, int l, int lane_, const bf16* PROJ_, const float* lru_conv_w_, const float* lru_conv_b_, const uint4* lruw, const float* lru_b_a_, const float* lru_b_x_, const float* sp, const float* HIN_,
                                            const float* lru_norm_, LAS float* hgl  , bf16* MIX_) {
    const int tt = unit & 127, b = unit >> 7, fr = lane_ & 15, q = lane_ >> 4;
    const size_t row0 = (size_t)b * SEQ + tt * 16;
    float ss[4] = {0.f, 0.f, 0.f, 0.f};
#pragma unroll 1
    for (int n = 0; n < 8; ++n) { float av[2][4], uv[2][4];
        lru_tile_block(PROJ_, row0, tt * 16, n, lane_, lru_conv_w_ + l * 1024, lru_conv_b_ + l * 256, lruw, lru_b_a_ + l * 256, lru_b_x_ + l * 256, sp, av, uv);
#pragma unroll
        for (int hf = 0; hf < 2; ++hf) { const int c = 32 * n + 16 * hf + fr;
            float Ap[4], Bp[4]; Ap[0] = av[hf][0]; Bp[0] = uv[hf][0];
#pragma unroll
            for (int g = 1; g < 4; ++g) { Ap[g] = av[hf][g] * Ap[g - 1]; Bp[g] = av[hf][g] * Bp[g - 1] + uv[hf][g]; }
            float hh = HIN_[(size_t)unit * 256 + c];
#pragma unroll
            for (int g = 0; g < 3; ++g) { const float Ag = __shfl(Ap[3], fr + 16 * g), Bg = __shfl(Bp[3], fr + 16 * g); if (g < q) hh = Ag * hh + Bg; }
#pragma unroll
            for (int g = 0; g < 4; ++g) { const float hv = Ap[g] * hh + Bp[g]; const float gt = bf2f(PROJ_[(row0 + 4 * q + g) * NPROJ + PBG + c]); const float v = hv * pg8::gelu_tanh_f(gt); hgl[(4 * q + g) * 256 + c] = v; ss[g] += v * v; } }
    }
    const float* ln = lru_norm_ + l * 256; float rs[4];
#pragma unroll
    for (int g = 0; g < 4; ++g) { float s = ss[g]; s += __shfl_xor(s, 1); s += __shfl_xor(s, 2); s += __shfl_xor(s, 4); s += __shfl_xor(s, 8); rs[g] = 1.f / sqrtf(s * (1.f / 256.f) + EPS); }
    bf16* mix0 = MIX_ + (row0 + 4 * q) * DM + OB + fr;
#pragma unroll 1
    for (int n = 0; n < 8; ++n) { const float gn0 = ln[32 * n + fr], gn1 = ln[32 * n + 16 + fr];
#pragma unroll
        for (int g = 0; g < 4; ++g) { const unsigned w = cvtpk(hgl[(4 * q + g) * 256 + 32 * n + fr] * rs[g] * gn0, hgl[(4 * q + g) * 256 + 32 * n + 16 + fr] * rs[g] * gn1);
            bf16* mp = mix0 + (size_t)g * DM + 32 * n; mp[0] = (bf16)w; mp[16] = (bf16)(w >> 16); } }
}

typedef short v4i16_t __attribute__((ext_vector_type(4)));
struct SwaUnit { int p, b, h, d, res, nb; };
__device__ __forceinline__ SwaUnit swa_decode(int u) { SwaUnit s; s.p = u / 1536; const int v = u % 1536; s.b = v / 96; s.h = (v >> 4) % 6; const int rb = v & 15;
    if (s.p == 0) { s.d = 1; s.res = 0; s.nb = rb; } else if (s.p == 1) { s.d = 4; s.res = rb >> 2; s.nb = rb & 3; } else { s.d = 16; s.res = rb; s.nb = 0; } return s; }
__device__ __forceinline__ void swa_fetch(const SwaUnit& s, int tq, const bf16* __restrict__ PROJ_, u32x4v (&kr)[8], u32x4v (&vr)[8]) {
    const size_t rowb = (size_t)s.b * SEQ;
#pragma unroll
    for (int i = 0; i < 8; ++i) { const int id = tq + 256 * i, row = id >> 3, ch = id & 7;
        if (s.nb > 0 || row >= 128) { const size_t tok = rowb + (size_t)((128 * (s.nb - 1) + row) * s.d + s.res); const bf16* src = PROJ_ + tok * NPROJ + s.h * 64 + 8 * ch;
            kr[i] = *(const u32x4v*)(src + PCK); vr[i] = *(const u32x4v*)(src + PCV); } }
}
__device__ __forceinline__ int swa_gunit(int k, int grp_) { return (k / 192) * 1536 + grp_ * 192 + (k % 192); }
__device__ __forceinline__ void swa_phase(int kfirst, int kstep, int grp_, int wv, int lane_, int tq, LAS unsigned char* ldsK, LAS unsigned char* ldsV, const bf16* __restrict__ PROJ_, bf16* __restrict__ OP_, float* __restrict__ LSE_) {
    u32x4v kr[8], vr[8];
    if (kfirst < 576) swa_fetch(swa_decode(swa_gunit(kfirst, grp_)), tq, PROJ_, kr, vr);
    for (int k = kfirst; k < 576; k += kstep) {
        const SwaUnit s = swa_decode(swa_gunit(k, grp_)); const int p = s.p, h = s.h, d = s.d, res = s.res, nb = s.nb;
        const size_t rowb = (size_t)s.b * SEQ;
        const int r = lane_ & 31, hh = lane_ >> 5;
        const size_t qtok = rowb + (size_t)((128 * nb + 32 * wv + r) * d + res);
        bf16x8v qf[4];
#pragma unroll
        for (int sx = 0; sx < 4; ++sx) qf[sx] = *(const bf16x8v*)(PROJ_ + qtok * NPROJ + PCQ + h * 64 + 16 * sx + 8 * hh);
#pragma unroll
        for (int i = 0; i < 8; ++i) { const int id = tq + 256 * i, row = id >> 3, ch = id & 7;
            if (nb > 0 || row >= 128) { *(LAS u32x4v*)(ldsK + row * 128 + ((ch ^ (row & 7)) << 4)) = kr[i]; *(LAS u32x4v*)(ldsV + row * 128 + (ch << 4)) = vr[i]; } }
        __syncthreads();
        if (k + kstep < 576) swa_fetch(swa_decode(swa_gunit(k + kstep, grp_)), tq, PROJ_, kr, vr);
        f32x16 P[5]; float mx = -1e30f;
#pragma unroll
        for (int kt2 = 0; kt2 < 5; ++kt2) { const int kt = wv + kt2;
            if (nb > 0 || kt >= 4) { f32x16 acc;
#pragma unroll
                for (int i = 0; i < 16; ++i) acc[i] = 0.f;
                const int row = 32 * kt + r;
#pragma unroll
                for (int sx = 0; sx < 4; ++sx) { const bf16x8v kf = *(const LAS bf16x8v*)(ldsK + row * 128 + (((2 * sx + hh) ^ (row & 7)) << 4)); acc = MFMA32(kf, qf[sx], acc); }
#pragma unroll
                for (int i = 0; i < 16; ++i) { const int krow = (i & 3) + 8 * (i >> 2) + 4 * hh; float sv = acc[i];
                    if (kt2 == 0 && krow < r) sv = -1e30f; if (kt2 == 4 && krow > r) sv = -1e30f; P[kt2][i] = sv; mx = fmaxf(mx, sv); }
            } else {
#pragma unroll
                for (int i = 0; i < 16; ++i) P[kt2][i] = -1e30f; }
        }
        mx = fmaxf(mx, __shfl_xor(mx, 32));
        float ls = 0.f;
#pragma unroll
        for (int kt2 = 0; kt2 < 5; ++kt2)
#pragma unroll
            for (int i = 0; i < 16; ++i) { const float e = __builtin_amdgcn_exp2f(P[kt2][i] - mx); P[kt2][i] = e; ls += e; }
        ls += __shfl_xor(ls, 32);
        const float inv = __builtin_amdgcn_rcpf(ls);
        if (hh == 0) LSE_[((size_t)p * M + qtok) * 8 + h] = mx + __builtin_amdgcn_logf(ls);
        f32x16 O0, O1;
#pragma unroll
        for (int i = 0; i < 16; ++i) { O0[i] = 0.f; O1[i] = 0.f; }
        const int i16 = lane_ & 15, g1 = (lane_ >> 4) & 1;
#pragma unroll
        for (int kt2 = 0; kt2 < 5; ++kt2) { const int kt = wv + kt2;
            if (nb > 0 || kt >= 4) {
#pragma unroll
                for (int i = 0; i < 16; ++i) P[kt2][i] *= inv;
#pragma unroll
                for (int sp = 0; sp < 2; ++sp) { const bf16x8v pf = pack8v(P[kt2], 8 * sp);
                    const int key = 32 * kt + 16 * sp + 4 * hh + (i16 >> 2);
#pragma unroll
                    for (int dt = 0; dt < 2; ++dt) { LAS unsigned char* vp = ldsV + key * 128 + (32 * dt + 16 * g1 + 4 * (i16 & 3)) * 2;
                        const v4i16_t lo = __builtin_amdgcn_ds_read_tr16_b64_v4i16((LAS v4i16_t*)vp), hi = __builtin_amdgcn_ds_read_tr16_b64_v4i16((LAS v4i16_t*)(vp + 1024));
                        const bf16x8v vf = {lo[0], lo[1], lo[2], lo[3], hi[0], hi[1], hi[2], hi[3]};
                        if (dt == 0) O0 = MFMA32(pf, vf, O0); else O1 = MFMA32(pf, vf, O1); } }
            }
        }
        { bf16* op0 = OP_ + ((size_t)p * M + rowb + (size_t)((128 * nb + 32 * wv + 4 * hh) * d + res)) * 384 + h * 64 + r; const size_t sd = (size_t)d * 384;
#pragma unroll
            for (int i = 0; i < 16; ++i) { bf16* op = op0 + (size_t)((i & 3) + 8 * (i >> 2)) * sd; const unsigned w = cvtpk(O0[i], O1[i]); op[0] = (bf16)w; op[32] = (bf16)(w >> 16); } }
        __syncthreads();
    }
}
#define x_in ((const float*)a.p[0 + zoff])
#define norm_mix ((const float*)a.p[1 + zoff])
#define w_in ((const float*)a.p[2 + zoff])
#define gla_w_gate ((const float*)a.p[3 + zoff])
#define gla_b_gate ((const float*)a.p[4 + zoff])
#define gla_norm ((const float*)a.p[5 + zoff])
#define lru_conv_w ((const float*)a.p[6 + zoff])
#define lru_conv_b ((const float*)a.p[7 + zoff])
#define lru_w_a ((const float*)a.p[8 + zoff])
#define lru_b_a ((const float*)a.p[9 + zoff])
#define lru_w_x ((const float*)a.p[10 + zoff])
#define lru_b_x ((const float*)a.p[11 + zoff])
#define lru_lambda ((const float*)a.p[12 + zoff])
#define lru_norm ((const float*)a.p[13 + zoff])
#define swa_norm ((const float*)a.p[14 + zoff])
#define w_out ((const float*)a.p[15 + zoff])
#define norm_ffn ((const float*)a.p[16 + zoff])
#define ffn_w_up ((const float*)a.p[17 + zoff])
#define ffn_conv_w ((const float*)a.p[18 + zoff])
#define ffn_conv_b ((const float*)a.p[19 + zoff])
#define ffn_w_down ((const float*)a.p[20 + zoff])
#define norm_final ((const float*)a.p[21 + zoff])
#define X ((float*)a.p[22 + zoff])
#define WSB ((unsigned char*)a.p[23 + zoff])
#define cosT ((float*)(WSB + WS_COS))
#define sinT ((float*)(WSB + WS_SIN))
#define WSET(l_) (((l_) == 0) ? (WSB + WS_W0) : ((unsigned char*)X + (size_t)40 * MiB + (size_t)((l_) - 1) * WSET_BYTES))
#define XB ((bf16*)(WSB + WS_XB))
#define PROJ ((bf16*)(WSB + WS_PROJ))
#define ACT ((bf16*)(WSB + WS_ACT + (size_t)grp * (2 * MiB)))
#define MIX ((bf16*)(WSB + WS_MIX))
#define US ((bf16*)(WSB + WS_US))
#define DBUF ((float*)(WSB + WS_DB))
#define PREBUF ((float*)(WSB + WS_MIX + (size_t)grp * (8 * MiB)) - (size_t)(grp * 16) * 2 * NUP)
#define RAWBUF ((float*)(WSB + WS_MIX + (size_t)grp * (8 * MiB) + MiB) - (size_t)(grp * 16) * 2 * NUP)
#define SSBUF ((bf16*)X)
#define HINBUF ((float*)(WSB + WS_HIN))
#define SSP ((float*)(WSB + WS_SSP))
#define OPBUF ((bf16*)(WSB + WS_OP))
#define LSEBUF ((float*)(WSB + WS_LSE))
#define PBUF ((float*)(WSB + WS_PB))
#define QBUF ((float*)(WSB + WS_QB))
#define tid tid_
#define lane (tid_ & 63)
#define wave (__builtin_amdgcn_readfirstlane(tid_ >> 6))
#define G ((int)gridDim.x)
#define gtid gt_
#define gsz ((int)(gridDim.x * 512))
#define gw ((int)(blockIdx.x * 8) + wave)
#define gwg (wgi * 8 + wave)
#define NGWG (NWG_G * 8)
#define NGW ((int)(gridDim.x * 8))
struct Args { void* p[24]; double inv_freq[8]; int ph_lo, ph_hi; };
#define PHASE_BEGIN int zoff = 0; asm volatile("" : "+s"(zoff)); int tid_; asm volatile("v_mbcnt_lo_u32_b32 %0, -1, 0\n\tv_mbcnt_hi_u32_b32 %0, -1, %0" : "=v"(tid_)); tid_ += wv_s * 64; const int gt_ = (int)(blockIdx.x * 512) + tid_;
#define CONVERT_WEIGHTS(l_) convert_layer_weights((l_), WSET(l_), gw, NGW, lane, lds + wave * 16384, gtid, gsz, norm_mix, w_in, gla_w_gate, w_out, norm_ffn, ffn_w_up, ffn_w_down, lru_w_a, lru_w_x, lru_lambda)

__global__ void __launch_bounds__(512, 2) fwd(Args a) {
    extern __shared__ __attribute__((aligned(16))) unsigned char lds_raw[];
    LAS unsigned char* lds = (LAS unsigned char*)lds_raw;
    for (int u = (int)threadIdx.x; u < (LDS_BYTES - RING_BYTES) / 4; u += 512) ((LAS unsigned*)(lds + RING_BYTES))[u] = 0u;
    __syncthreads();
    const int wv_s = __builtin_amdgcn_readfirstlane((int)threadIdx.x >> 6);
    const int lo = a.ph_lo, hi = a.ph_hi;
    unsigned* barw; { int zoff = 0; asm volatile("" : "+s"(zoff)); barw = (unsigned*)(WSB + WS_CTL) + CW_BAR; }
    const bool fused = (hi - lo) > 1;
    const int grp = (int)(blockIdx.x & 7), wgi = (int)(blockIdx.x >> 3), NWG_G = (int)(gridDim.x >> 3);
    XcdBarrier barG; barG.bar = barw; barG.x = 0; barG.ng = gridDim.x; barG.st = nullptr;
    XcdBarrier bar; bar.bar = barw + (1 + grp) * XCD_BAR_WORDS; bar.x = 0; bar.ng = (unsigned)NWG_G; bar.st = nullptr;
    if (fused) { barG = xcd_barrier_post(barw, (volatile LAS unsigned*)(lds + MISC_OFF) + 8, gridDim.x); bar = xcd_barrier_post(barw + (1 + grp) * XCD_BAR_WORDS, (volatile LAS unsigned*)(lds + MISC_OFF) + 12, (unsigned)NWG_G); }
#define IN(k) (lo <= (k) && (k) < hi)
#define SEAM() do { if (fused) { XcdBarrier b_ = bar; asm volatile("" : "+s"(b_.bar), "+s"(b_.x)); xcd_barrier(b_); } } while (0)
#define SEAMG() do { if (fused) { XcdBarrier b_ = barG; asm volatile("" : "+s"(b_.bar), "+s"(b_.x)); xcd_barrier(b_); } } while (0)

    if (IN(P_PRO)) { PHASE_BEGIN
        for (int row = gw; row < M; row += NGW) { const f32x4* xr = (const f32x4*)(x_in + (size_t)row * DM) + lane; uint2* xb = (uint2*)(XB + (size_t)row * DM) + lane; float s = 0.f;
#pragma unroll
            for (int j = 0; j < 4; ++j) { const f32x4 v = xr[64 * j]; xb[64 * j] = make_uint2(pk2(v.x, v.y), pk2(v.z, v.w)); s += (v.x * v.x + v.y * v.y) + (v.z * v.z + v.w * v.w); }
            s = wave_sum(s); if (lane < 16) SSP[(size_t)row * 16 + lane] = (lane == 0) ? s : 0.f; }
        for (int t = gtid; t < SEQ; t += gsz) {
#pragma unroll
            for (int j = 0; j < 8; ++j) { double rv = (double)t * a.inv_freq[j] * 0.15915494309189535; rv -= floor(rv);
                cosT[t * 8 + j] = __builtin_amdgcn_cosf((float)rv); sinT[t * 8 + j] = __builtin_amdgcn_sinf((float)rv); } }
        for (int lw = 0; lw < DEPTH; ++lw) CONVERT_WEIGHTS(lw);
    }
    SEAMG();

    for (int l = 0; l < DEPTH; ++l) {
        const int pb = 1 + l * PPL;
        if (IN(pb + L_INPROJ)) { PHASE_BEGIN
            pg8::Gemm g{XB, (const bf16*)(WSET(l) + WO_IN), M, NPROJ, DM}; pg8::StaticOrder S; S.init(M, NPROJ, G, (int)blockIdx.x);
            pg8::EpiScaleBf16 E{PROJ, NPROJ, SSP};
            pg8::gemm_phase<pg8::EpiScaleBf16, pg8::StaticOrder, true, true>(lds, g, S, E, tid);
        }
        SEAM();
        if (IN(pb + L_MA)) { PHASE_BEGIN
            {
                const bf16* __restrict__ pj = PROJ; const float* __restrict__ ct = cosT; const float* __restrict__ st = sinT;
                const int gt_l = wgi * 512 + tid, gsz_l = NWG_G * 512, it0 = grp * (M / 8) * 12, it1 = it0 + (M / 8) * 12;
                for (int b0 = it0 + gt_l; b0 < it1; b0 += 3 * gsz_l) {
                uint4 xa[3], xb_[3]; f32x4 c0[3], c1[3], s0[3], s1[3];
#pragma unroll
                for (int k = 0; k < 3; ++k) { const int it = (b0 + k * gsz_l < it1) ? b0 + k * gsz_l : b0; const int h = it % 6, w = (it / 6) & 1, row = it / 12, t = row & (SEQ - 1);
                    const bf16* p = pj + (size_t)row * NPROJ + (w ? PCK : PCQ) + h * 64; xa[k] = *(const uint4*)p; xb_[k] = *(const uint4*)(p + 8);
                    c0[k] = *(const f32x4*)(ct + t * 8); c1[k] = *(const f32x4*)(ct + t * 8 + 4); s0[k] = *(const f32x4*)(st + t * 8); s1[k] = *(const f32x4*)(st + t * 8 + 4); }
#pragma unroll
                for (int k = 0; k < 3; ++k) { if (k > 0 && b0 + k * gsz_l >= it1) break; const int it = b0 + k * gsz_l; const int h = it % 6, w = (it / 6) & 1, row = it / 12;
                    bf16* p = PROJ + (size_t)row * NPROJ + (w ? PCK : PCQ) + h * 64; float x1[8], x2[8]; unpack8(xa[k], x1); unpack8(xb_[k], x2);
                    const float cc[8] = {c0[k][0], c0[k][1], c0[k][2], c0[k][3], c1[k][0], c1[k][1], c1[k][2], c1[k][3]}, sn_[8] = {s0[k][0], s0[k][1], s0[k][2], s0[k][3], s1[k][0], s1[k][1], s1[k][2], s1[k][3]};
                    float y1[8], y2[8];
#pragma unroll
                    for (int e = 0; e < 8; ++e) { y1[e] = x1[e] * cc[e] - x2[e] * sn_[e]; y2[e] = x2[e] * cc[e] + x1[e] * sn_[e]; }
                    *(uint4*)p = make_uint4(pk2(y1[0], y1[1]), pk2(y1[2], y1[3]), pk2(y1[4], y1[5]), pk2(y1[6], y1[7]));
                    *(uint4*)(p + 8) = make_uint4(pk2(y2[0], y2[1]), pk2(y2[2], y2[3]), pk2(y2[4], y2[5]), pk2(y2[6], y2[7])); }
                }
            }
            for (int u = grp * 512 + gwg; u < (grp + 1) * 512; u += NGWG) gla_m1_unit(u, l, lane, PROJ, gla_b_gate, US, DBUF);
            for (int u = grp * 256 + gwg; u < (grp + 1) * 256; u += NGWG) lru_m1_unit(u, l, lane, PROJ, lru_conv_w, lru_conv_b, (const uint4*)(WSET(l) + WO_LRUW), lru_b_a, lru_b_x, (const float*)(WSET(l) + WO_LRUSP), PBUF, QBUF);
        }
        SEAM();
        if (IN(pb + L_MB)) { PHASE_BEGIN
            { const int nit = 8 * 96 * 6, per = (nit + NWG_G - 1) / NWG_G;
                if (tid < per) { const int it = wgi * per + tid; if (it < nit) gla_m2_item(grp * nit + it, US, SSBUF, DBUF); }
                const int nit2 = 2 * 256, per2 = (nit2 + NWG_G - 1) / NWG_G;
                if (tid >= 256 && tid < 256 + per2) { const int it = wgi * per2 + tid - 256; if (it < nit2) lru_m2_item(grp * nit2 + it, PBUF, QBUF, HINBUF); } }
            { const int half = wave >> 2; LAS unsigned char* lk = lds + half * 65536;
                swa_phase(wgi * 2 + half, 2 * NWG_G, grp, wave & 3, lane, tid & 255, lk, lk + 32768, PROJ, OPBUF, LSEBUF); }
        }
        SEAM();
        if (IN(pb + L_MC)) { PHASE_BEGIN
            for (int u = grp * 512 + gwg; u < (grp + 1) * 512; u += NGWG) gla_m3_unit(u, l, lane, PROJ, gla_b_gate, gla_norm, SSBUF, MIX);
            for (int u = grp * 256 + gwg; u < (grp + 1) * 256; u += NGWG) lru_m3_unit(u, l, lane, PROJ, lru_conv_w, lru_conv_b, (const uint4*)(WSET(l) + WO_LRUW), lru_b_a, lru_b_x, (const float*)(WSET(l) + WO_LRUSP), HINBUF, lru_norm, (LAS float*)(lds + wave * 16384), MIX);
            {
                const float* __restrict__ sn = swa_norm + l * 384; const float* __restrict__ lseb = LSEBUF; const bf16* __restrict__ opb = OPBUF; bf16* __restrict__ mixb = MIX;
                const int cl = lane < 48 ? lane : 47, hd = cl >> 3;
                float sng[8]; { const f32x4 a0 = *(const f32x4*)(sn + 8 * cl), a1 = *(const f32x4*)(sn + 8 * cl + 4); sng[0] = a0[0]; sng[1] = a0[1]; sng[2] = a0[2]; sng[3] = a0[3]; sng[4] = a1[0]; sng[5] = a1[1]; sng[6] = a1[2]; sng[7] = a1[3]; }
                for (int row = grp * (M / 8) + gwg; row < (grp + 1) * (M / 8); row += 2 * NGWG) {
                    float lv[2][3]; uint4 ov[2][3];
#pragma unroll
                    for (int rr = 0; rr < 2; ++rr)
#pragma unroll
                        for (int p = 0; p < 3; ++p) { const size_t r_ = (size_t)p * M + row + rr * NGWG; lv[rr][p] = lseb[r_ * 8 + hd]; ov[rr][p] = *(const uint4*)(opb + r_ * 384 + 8 * cl); }
#pragma unroll
                    for (int rr = 0; rr < 2; ++rr) { const float l0 = lv[rr][0], l1 = lv[rr][1], l2 = lv[rr][2];
                        const float ml = fmaxf(l0, fmaxf(l1, l2)), w0 = __builtin_amdgcn_exp2f(l0 - ml), w1 = __builtin_amdgcn_exp2f(l1 - ml), w2 = __builtin_amdgcn_exp2f(l2 - ml), wi = __builtin_amdgcn_rcpf(w0 + w1 + w2);
                        float o0[8], o1[8], o2[8], e[8]; unpack8(ov[rr][0], o0); unpack8(ov[rr][1], o1); unpack8(ov[rr][2], o2); float s = 0.f;
#pragma unroll
                        for (int k = 0; k < 8; ++k) { e[k] = (w0 * o0[k] + w1 * o1[k] + w2 * o2[k]) * wi; s += e[k] * e[k]; }
                        if (lane >= 48) s = 0.f;
                        const float rs = __builtin_amdgcn_rsqf(wave_sum(s) * (1.f / 384.f) + EPS);
                        if (lane < 48) *(uint4*)(mixb + (size_t)(row + rr * NGWG) * DM + OC + 8 * cl) = make_uint4(pk2(e[0] * rs * sng[0], e[1] * rs * sng[1]), pk2(e[2] * rs * sng[2], e[3] * rs * sng[3]), pk2(e[4] * rs * sng[4], e[5] * rs * sng[5]), pk2(e[6] * rs * sng[6], e[7] * rs * sng[7])); }
                }
            }
        }
        SEAM();
        if (IN(pb + L_OUTPROJ)) { PHASE_BEGIN
            pg8::Gemm g{MIX, (const bf16*)(WSET(l) + WO_OUT), M, DM, DM}; pg8::StaticOrder S; S.init(M, DM, G, (int)blockIdx.x);
            pg8::EpiResid E{XB, DM, SSP};
            pg8::gemm_phase<pg8::EpiResid, pg8::StaticOrder, true, true>(lds, g, S, E, tid);
        }
        SEAM();
        if (IN(pb + L_UP)) { PHASE_BEGIN
            pg8::Gemm g{XB, (const bf16*)(WSET(l) + WO_UP), M, NUP, DM}; pg8::StaticOrder S; S.init(M, NUP, G, (int)blockIdx.x);
            pg8::EpiFfnUp E{ACT, SSP, ffn_conv_w + (size_t)l * 3 * NUP, ffn_conv_b + (size_t)l * NUP, PREBUF, RAWBUF, (LAS float*)(lds + HALO_OFF), FFN, NUP};
            pg8::gemm_phase<pg8::EpiFfnUp, pg8::StaticOrder, true, true>(lds, g, S, E, tid);
        }
        SEAM();
        if (IN(pb + L_DOWN)) { PHASE_BEGIN
            pg8::Gemm g{ACT, (const bf16*)(WSET(l) + WO_DN), M, DM, FFN}; pg8::StaticOrder S; S.init(M, DM, G, (int)blockIdx.x);
            {
                const float* cw = ffn_conv_w + (size_t)l * 3 * NUP; pg8::Unit uu;
                for (int ui = 0; S.next(ui, uu); ++ui) { const int pm = uu.pm; if ((pm & 7) == 0) continue;
                    const float* __restrict__ pre0 = PREBUF + (size_t)(pm * 2) * NUP; const float* __restrict__ r0 = RAWBUF + (size_t)((pm - 1) * 2) * NUP; const float* __restrict__ r1 = r0 + NUP; const float* __restrict__ cwr = cw;
                    bf16* __restrict__ act0 = ACT + (size_t)(pm * 256) * FFN;
                    for (int j = tid; j < FFN; j += 512) {
                        const float pv0 = pre0[j], pg0 = pre0[FFN + j], pv1 = pre0[NUP + j], pg1 = pre0[NUP + FFN + j];
                        const float a0v = r0[j], a0g = r0[FFN + j], a1v = r1[j], a1g = r1[FFN + j];
                        const float w0v = cwr[j], w0g = cwr[FFN + j], w1v = cwr[NUP + j], w1g = cwr[NUP + FFN + j];
                        const float v0 = pv0 + w1v * a1v + w0v * a0v, g0 = pg0 + w1g * a1g + w0g * a0g, v1 = pv1 + w0v * a1v, g1 = pg1 + w0g * a1g;
                        act0[j] = f2bf(gelu_tanh(g0) * v0); act0[FFN + j] = f2bf(gelu_tanh(g1) * v1); } }
                asm volatile("s_waitcnt vmcnt(0)" ::: "memory"); __syncthreads();
            }
            pg8::EpiResid E{XB, DM, SSP};
            pg8::gemm_phase<pg8::EpiResid, pg8::StaticOrder, true, true>(lds, g, S, E, tid);
        }
        SEAM();
    }
    SEAMG();
    if (IN(P_FIN)) { PHASE_BEGIN
        for (int row = grp * (M / 8) + gwg; row < (grp + 1) * (M / 8); row += NGWG) { f32x4* xo = (f32x4*)(X + (size_t)row * DM) + lane; const uint2* xb = (const uint2*)(XB + (size_t)row * DM) + lane; const f32x4* sp = (const f32x4*)(SSP + (size_t)row * 16);
            const f32x4 p0 = sp[0], p1 = sp[1], p2 = sp[2], p3 = sp[3]; const f32x4 ps = (p0 + p1) + (p2 + p3);
            const float rs = 1.f / sqrtf(((ps[0] + ps[1]) + (ps[2] + ps[3])) * (1.f / DM) + EPS);
#pragma unroll
            for (int j = 0; j < 4; ++j) { const f32x4 g4 = ((const f32x4*)norm_final)[lane + 64 * j]; const uint2 u = xb[64 * j];
                f32x4 v; v.x = __uint_as_float(u.x << 16); v.y = __uint_as_float(u.x & 0xffff0000u); v.z = __uint_as_float(u.y << 16); v.w = __uint_as_float(u.y & 0xffff0000u); xo[64 * j] = v * rs * g4; } }
    }
#undef IN
#undef SEAM
}

extern "C" void kernel_launch(void* const* d_in, const int* in_sizes, int n_in, void* d_out, int out_size, void* d_ws, size_t ws_size, hipStream_t stream) {
    static int grid = 0;
    if (grid == 0) {
        if (n_in != 22 || in_sizes[0] != M * DM || out_size != M * DM || ws_size < WS_END) { fprintf(stderr, "kernel_launch: unexpected shapes: n_in %d in0 %d out %d ws %zu (need %zu)\n", n_in, n_in > 0 ? in_sizes[0] : -1, out_size, ws_size, (size_t)WS_END); grid = -1; return; }
        int dev = 0, cus = 0, per_cu = 0;
        if (hipGetDevice(&dev) != hipSuccess || hipDeviceGetAttribute(&cus, hipDeviceAttributeMultiprocessorCount, dev) != hipSuccess) { grid = -1; return; }
        if (hipFuncSetAttribute((const void*)fwd, hipFuncAttributeMaxDynamicSharedMemorySize, LDS_BYTES) != hipSuccess) { fprintf(stderr, "kernel_launch: hipFuncSetAttribute failed\n"); grid = -1; return; }
        if (hipOccupancyMaxActiveBlocksPerMultiprocessor(&per_cu, (const void*)fwd, 512, LDS_BYTES) != hipSuccess || per_cu < 1) fprintf(stderr, "kernel_launch: occupancy query says %d\n", per_cu);
        (void)hipGetLastError();
        grid = cus;
    }
    if (grid < 0) return;
    (void)hipMemsetAsync((char*)d_ws + WS_CTL, 0, CTL_ZERO_BYTES, stream);
    Args a{};
    for (int i = 0; i < 22; ++i) a.p[i] = d_in[i];
    a.p[22] = d_out; a.p[23] = d_ws;
    const double invf[8] = {1.0, 0.19392274474868576, 0.03760603093086393, 0.007292664737217109, 0.001414213562373095, 0.0002742481756762073, 5.318295896944988e-05, 1.031338537721246e-05};
    for (int j = 0; j < 8; ++j) a.inv_freq[j] = invf[j];
#if MK_ONE_LAUNCH
    a.ph_lo = 0; a.ph_hi = NPH;
    hipLaunchKernelGGL(fwd, dim3(grid), dim3(512), LDS_BYTES, stream, a);
#else
    for (int p = 0; p < NPH; ++p) { a.ph_lo = p; a.ph_hi = p + 1; hipLaunchKernelGGL(fwd, dim3(grid), dim3(512), LDS_BYTES, stream, a); }
#endif
}
```

```cpp
#include <hip/hip_runtime.h>
#include <cstdio>
#include <cstdint>
namespace pg8 {
#define PG8_LAS __attribute__((address_space(3)))
typedef unsigned short bf16_t;
typedef short bf16x8 __attribute__((ext_vector_type(8)));
typedef float f32x4 __attribute__((ext_vector_type(4)));
typedef unsigned u32x4 __attribute__((ext_vector_type(4)));
constexpr int BM = 256, BK = 64, HALF = 128, HTB = HALF * BK * 2  , STAGE_BYTES = 8 * HTB, NXCD = 8, WGM = 8;

__host__ __device__ __forceinline__ int lds_byte(int r, int c) { const int st = (r >> 4) * 2 + (c >> 5), rr = r & 15, cc = c & 31, ob = rr * 64 + cc * 2; return st * 1024 + (ob ^ (((ob >> 9) & 1) << 5)); }
__host__ __device__ __forceinline__ void stage_rc(int b, int& R, int& C) { const int st = b / 1024, sb = b % 1024, swz = sb ^ (((sb >> 9) & 1) << 5); R = (st >> 1) * 16 + swz / 64; C = (st & 1) * 32 + (swz % 64) / 2; }
__host__ __device__ __forceinline__ int perm32(int rho) { const int n = rho >> 4, i = rho & 15; return 8 * (i >> 2) + 4 * n + (i & 3); }

struct Unit { int pm, pn; };
struct Gemm { const bf16_t* A; const bf16_t* Bt; int M, N, K; };

struct StaticOrder {
    int nM, nN, nwg, G, c;
    __host__ __device__ void init(int M, int N, int G_, int c_) { nM = M / BM; nN = N / BM; nwg = nM * nN; G = G_; c = c_; }
    __host__ __device__ bool next(int i, Unit& u) const {
        const long L = (long)i * G + c; if (L >= nwg) return false;
        int wgid = (int)L; { const int q = nwg / NXCD, r = nwg % NXCD, xcd = wgid % NXCD, off = wgid / NXCD; wgid = (xcd < r ? xcd * (q + 1) : r * (q + 1) + (xcd - r) * q) + off; }
        const int nig = WGM * nN, gid = wgid / nig, fm = gid * WGM, gsz = (nM - fm) < WGM ? (nM - fm) : WGM;
        u.pm = fm + ((wgid % nig) % gsz); u.pn = (wgid % nig) / gsz; return true;
    }
    __device__ __forceinline__ void a_ready(const Unit&) const {}
    __device__ __forceinline__ void done(const Unit&) const {}
};

__device__ __forceinline__ unsigned cvt_pk_bf16(float lo, float hi) { unsigned r; asm volatile("v_cvt_pk_bf16_f32 %0, %1, %2" : "=v"(r) : "v"(lo), "v"(hi)); return r; }
typedef float f32x2 __attribute__((ext_vector_type(2)));
__device__ __forceinline__ f32x2 gelu_pk(f32x2 v) {
    const f32x2 av = __builtin_elementwise_abs(v), d = av * 0.2316418882f + 1.0f;
    f32x2 t; t.x = __builtin_amdgcn_rcpf(d.x); t.y = __builtin_amdgcn_rcpf(d.y);
    f32x2 q = t * 0.5307027145f + (-0.7265760135f); q = q * t + 0.7107068705f; q = q * t + (-0.142248368f); q = q * t + 0.127414796f; q = q * t;
    const f32x2 s = (v * v) * (-0.72134752044f);
    f32x2 e; e.x = __builtin_amdgcn_exp2f(s.x); e.y = __builtin_amdgcn_exp2f(s.y);
    const f32x2 m = v * (q * e), r = v - m;
    f32x2 o; o.x = v.x < 0.f ? m.x : r.x; o.y = v.y < 0.f ? m.y : r.y; return o;
}


typedef unsigned u32x2 __attribute__((ext_vector_type(2)));
__device__ __forceinline__ float row_rstd(const float* ssp, int row, int fq) {
    const f32x4 p = *(const f32x4*)(ssp + (size_t)row * 16 + 4 * fq); float s = (p[0] + p[1]) + (p[2] + p[3]);
    s += __shfl_xor(s, 16); s += __shfl_xor(s, 32); return __builtin_amdgcn_rsqf(s * (1.f / 1024.f) + 1e-6f); }
struct EpiScaleBf16 {
    static constexpr bool PERM = true, AFTER_DRAIN = false;
    bf16_t* O; int ldc; const float* ssp;
    __device__ __forceinline__ void operator()(const f32x4 (&acc)[2][2][4][2], const Unit& u, int wr, int wc, int fr, int fq) const {
        const int row0 = u.pm * BM + wr * 64 + fr, col0 = u.pn * BM + wc * 32 + 8 * fq;
#pragma unroll
        for (int ai = 0; ai < 2; ++ai)
#pragma unroll
            for (int m = 0; m < 4; ++m) { const int row = row0 + ai * HALF + m * 16; const float s = row_rstd(ssp, row, fq); bf16_t* rowp = O + (size_t)row * ldc + col0;
#pragma unroll
                for (int bj = 0; bj < 2; ++bj) { const f32x4 v0 = acc[ai][bj][m][0] * s, v1 = acc[ai][bj][m][1] * s;
                    u32x4 w; w.x = cvt_pk_bf16(v0[0], v0[1]); w.y = cvt_pk_bf16(v0[2], v0[3]); w.z = cvt_pk_bf16(v1[0], v1[1]); w.w = cvt_pk_bf16(v1[2], v1[3]);
                    *(u32x4*)(rowp + bj * HALF) = w; } }
    }
};
struct EpiResid {
    static constexpr bool PERM = false, AFTER_DRAIN = false;
    bf16_t* XB; int ldc; float* ssp;
    __device__ __forceinline__ void operator()(const f32x4 (&acc)[2][2][4][2], const Unit& u, int wr, int wc, int fr, int fq) const {
        const int row0 = u.pm * BM + wr * 64 + fr, col0 = u.pn * BM + wc * 32 + 4 * fq;
#pragma unroll
        for (int ai = 0; ai < 2; ++ai)
#pragma unroll
            for (int m = 0; m < 4; ++m) { const int row = row0 + ai * HALF + m * 16; const size_t off = (size_t)row * ldc + col0; float q = 0.f;
#pragma unroll
                for (int bj = 0; bj < 2; ++bj)
#pragma unroll
                    for (int n = 0; n < 2; ++n) { u32x2* p = (u32x2*)(XB + off + bj * HALF + n * 16); const u32x2 o = *p;
                        const float v0 = __uint_as_float(o.x << 16) + acc[ai][bj][m][n][0], v1 = __uint_as_float(o.x & 0xffff0000u) + acc[ai][bj][m][n][1], v2 = __uint_as_float(o.y << 16) + acc[ai][bj][m][n][2], v3 = __uint_as_float(o.y & 0xffff0000u) + acc[ai][bj][m][n][3];
                        u32x2 w; w.x = cvt_pk_bf16(v0, v1); w.y = cvt_pk_bf16(v2, v3); *p = w;
                        const float r0 = __uint_as_float(w.x << 16), r1 = __uint_as_float(w.x & 0xffff0000u), r2 = __uint_as_float(w.y << 16), r3 = __uint_as_float(w.y & 0xffff0000u);
                        q += (r0 * r0 + r1 * r1) + (r2 * r2 + r3 * r3); }
                q += __shfl_xor(q, 16); q += __shfl_xor(q, 32);
                if (fq == 0) ssp[(size_t)row * 16 + u.pn * 4 + wc] = q; }
    }
};

__device__ __forceinline__ float dpp_ror1(float x) { return __builtin_bit_cast(float, __builtin_amdgcn_mov_dpp(__builtin_bit_cast(int, x), 0x121, 0xf, 0xf, true)); }
__device__ __forceinline__ float gelu_tanh_f(float x) { const float u2 = x * (2.302208198f + 0.1029432397f * x * x);
    return x * __builtin_amdgcn_rcpf(1.f + __builtin_amdgcn_exp2f(-u2)); }
struct EpiFfnUp {
    static constexpr bool PERM = true, AFTER_DRAIN = false, PERMA = true;
    bf16_t* ACT; const float* ssp; const float* cw; const float* cb; float* PRE; float* RAW; PG8_LAS float* halo; int nact  , nup  ;
    __device__ __forceinline__ void operator()(f32x4 (&acc)[2][2][4][2], const Unit& u, int wr, int wc, int fr_, int fq_) const {
        int fr = fr_, fq = fq_; asm volatile("" : "+v"(fr), "+v"(fq));
        const int row0 = u.pm * BM + wr * 64 + 4 * fr;
        const int jt = wc * 32 + 8 * fq;
#pragma unroll
        for (int ai = 0; ai < 2; ++ai)
#pragma unroll
            for (int m = 0; m < 4; ++m) { const float s = row_rstd(ssp, row0 + ai * HALF + m, fq);
#pragma unroll
                for (int bj = 0; bj < 2; ++bj)
#pragma unroll
                    for (int n = 0; n < 2; ++n) acc[ai][bj][m][n] = acc[ai][bj][m][n] * s; }
        if (fr == 15) {
#pragma unroll
            for (int ai = 0; ai < 2; ++ai) { const int B = 2 * ai + wr;
#pragma unroll
                for (int rr = 0; rr < 2; ++rr)
#pragma unroll
                    for (int bj = 0; bj < 2; ++bj)
#pragma unroll
                        for (int n = 0; n < 2; ++n) { *(PG8_LAS f32x4*)(halo + ((B * 2 + rr) * 256 + bj * HALF + jt + 4 * n)) = acc[ai][bj][2 + rr][n];
                            if (B == 3) *(f32x4*)(RAW + (size_t)(u.pm * 2 + rr) * nup + bj * nact + u.pn * HALF + jt + 4 * n) = acc[ai][bj][2 + rr][n]; } }
        }
        asm volatile("s_waitcnt lgkmcnt(0)" ::: "memory"); __builtin_amdgcn_s_barrier(); asm volatile("" ::: "memory");
        typedef float f32x2e __attribute__((ext_vector_type(2)));
#pragma unroll
        for (int n = 0; n < 2; ++n) {
            unsigned pk0[2][4];
#pragma unroll
            for (int ch = 0; ch < 2; ++ch) { const int j = u.pn * HALF + jt + 4 * n + 2 * ch;
                asm volatile("" ::: "memory"); __builtin_amdgcn_sched_barrier(0);
                const f32x2e w0v = *(const f32x2e*)(cw + j), w1v = *(const f32x2e*)(cw + nup + j), w2v = *(const f32x2e*)(cw + 2 * nup + j), bv = *(const f32x2e*)(cb + j);
                const f32x2e w0g = *(const f32x2e*)(cw + nact + j), w1g = *(const f32x2e*)(cw + nup + nact + j), w2g = *(const f32x2e*)(cw + 2 * nup + nact + j), bg = *(const f32x2e*)(cb + nact + j);
#pragma unroll
                for (int ai = 0; ai < 2; ++ai) { const int B = 2 * ai + wr;
                    f32x2e hv0 = {0.f, 0.f}, hv1 = hv0, hg0 = hv0, hg1 = hv0;
                    if (B > 0) { const int hc = jt + 4 * n + 2 * ch;
                        hv0 = *(const PG8_LAS f32x2e*)(halo + (((B - 1) * 2 + 0) * 256 + hc)); hv1 = *(const PG8_LAS f32x2e*)(halo + (((B - 1) * 2 + 1) * 256 + hc));
                        hg0 = *(const PG8_LAS f32x2e*)(halo + (((B - 1) * 2 + 0) * 256 + HALF + hc)); hg1 = *(const PG8_LAS f32x2e*)(halo + (((B - 1) * 2 + 1) * 256 + HALF + hc)); }
                    float yv[4][2], yg[4][2];
#pragma unroll
                    for (int k = 0; k < 2; ++k) { const int e = 2 * ch + k;
                        const float xv0 = acc[ai][0][0][n][e], xv1 = acc[ai][0][1][n][e], xv2 = acc[ai][0][2][n][e], xv3 = acc[ai][0][3][n][e];
                        const float xg0 = acc[ai][1][0][n][e], xg1 = acc[ai][1][1][n][e], xg2 = acc[ai][1][2][n][e], xg3 = acc[ai][1][3][n][e];
                        float rv3 = dpp_ror1(xv3), rv2 = dpp_ror1(xv2), rg3 = dpp_ror1(xg3), rg2 = dpp_ror1(xg2);
                        asm volatile("" : "+v"(rv3), "+v"(rv2), "+v"(rg3), "+v"(rg2));
                        const float sv3 = (fr == 0) ? hv1[k] : rv3, sv2 = (fr == 0) ? hv0[k] : rv2;
                        const float sg3 = (fr == 0) ? hg1[k] : rg3, sg2 = (fr == 0) ? hg0[k] : rg2;
                        yv[0][k] = bv[k] + w2v[k] * xv0 + w1v[k] * sv3 + w0v[k] * sv2; yv[1][k] = bv[k] + w2v[k] * xv1 + w1v[k] * xv0 + w0v[k] * sv3;
                        yv[2][k] = bv[k] + w2v[k] * xv2 + w1v[k] * xv1 + w0v[k] * xv0; yv[3][k] = bv[k] + w2v[k] * xv3 + w1v[k] * xv2 + w0v[k] * xv1;
                        yg[0][k] = bg[k] + w2g[k] * xg0 + w1g[k] * sg3 + w0g[k] * sg2; yg[1][k] = bg[k] + w2g[k] * xg1 + w1g[k] * xg0 + w0g[k] * sg3;
                        yg[2][k] = bg[k] + w2g[k] * xg2 + w1g[k] * xg1 + w0g[k] * xg0; yg[3][k] = bg[k] + w2g[k] * xg3 + w1g[k] * xg2 + w0g[k] * xg1; }
                    if (B == 0 && fr == 0) {
#pragma unroll
                        for (int m = 0; m < 2; ++m) { float* pp = PRE + (size_t)(u.pm * 2 + m) * nup + j; *(f32x2e*)pp = (f32x2e){yv[m][0], yv[m][1]}; *(f32x2e*)(pp + nact) = (f32x2e){yg[m][0], yg[m][1]}; } }
#pragma unroll
                    for (int m = 0; m < 4; ++m) { const unsigned w = cvt_pk_bf16(gelu_tanh_f(yg[m][0]) * yv[m][0], gelu_tanh_f(yg[m][1]) * yv[m][1]);
                        if (ch == 0) pk0[ai][m] = w;
                        else { u32x2 st; st.x = pk0[ai][m]; st.y = w; *(u32x2*)(ACT + (size_t)(row0 + ai * HALF + m) * nact + u.pn * HALF + jt + 4 * n) = st; } }
                }
            }
        }
    }
};
template <class E, class = void> struct pg8_has_perma { static constexpr bool v = false; };
template <class E> struct pg8_has_perma<E, decltype((void)E::PERMA)> { static constexpr bool v = E::PERMA; };
template <class E> __host__ __device__ constexpr bool pg8_perma() { return pg8_has_perma<E>::v; }
template <class Epi, class Sched, bool ALIGN_EPI = false, bool SP2 = false>
__device__ __forceinline__ void gemm_phase(PG8_LAS unsigned char* lds, const Gemm g, const Sched& S, const Epi& E, int tid_in) {
    int tid_l = tid_in; asm volatile("" : "+v"(tid_l));
    const int tid = tid_l, wid = __builtin_amdgcn_readfirstlane(tid >> 6), lane = tid & 63, wr = wid >> 2, wc = wid & 3, fr = lane & 15, fq = lane >> 4;
    const int K = g.K, nt = K / BK;
    unsigned voffA[2], voffB[2];
#pragma unroll
    for (int i = 0; i < 2; ++i) { int R, C; stage_rc(tid * 16 + i * 8192, R, C); const int Rb = Epi::PERM ? ((R & ~31) + perm32(R & 31)) : R;
        const int Ra = pg8_perma<Epi>() ? ((R & 64) | (4 * (R & 15) + ((R >> 4) & 3))) : R;
        voffA[i] = (unsigned)(Ra * K + C) * 2u; voffB[i] = (unsigned)(Rb * K + C) * 2u; }
    const size_t kstep = (size_t)(BK * 2);
    const size_t hstep = (size_t)HALF * K * 2;
    const size_t tstep = 2 * hstep;
    const unsigned ldsw = (unsigned)wid * 1024u;
    const int aoff = lds_byte(wr * 64 + fr, fq * 8), boff = lds_byte(wc * 32 + fr, fq * 8);
#define PG8_SA(b, h) (((b) * 2 + (h)) * HTB)
#define PG8_SB(b, h) ((4 + (b) * 2 + (h)) * HTB)
#define PG8_STAGE(bufoff, gbase, voff) do { _Pragma("unroll") for (int _i = 0; _i < 2; ++_i) \
        __builtin_amdgcn_global_load_lds((const unsigned*)((const char*)(gbase) + (voff)[_i]), (PG8_LAS unsigned*)(lds + (bufoff) + ldsw + _i * 8192), 16, 0, 0); } while (0)
#define PG8_LDA(dst, b, h) do { _Pragma("unroll") for (int m = 0; m < 4; ++m) _Pragma("unroll") for (int k = 0; k < 2; ++k) dst[m][k] = *(const PG8_LAS bf16x8*)(lds + PG8_SA(b, h) + aoff + m * 2048 + k * 1024); } while (0)
#define PG8_LDB(dst, b, h) do { _Pragma("unroll") for (int n = 0; n < 2; ++n) _Pragma("unroll") for (int k = 0; k < 2; ++k) dst[n][k] = *(const PG8_LAS bf16x8*)(lds + PG8_SB(b, h) + boff + n * 2048 + k * 1024); } while (0)
#define PG8_MMA(ai, bj, At, Bt) do { __builtin_amdgcn_s_setprio(1); _Pragma("unroll") for (int m = 0; m < 4; ++m) _Pragma("unroll") for (int n = 0; n < 2; ++n) _Pragma("unroll") for (int k = 0; k < 2; ++k) \
        acc[ai][bj][m][n] = __builtin_amdgcn_mfma_f32_16x16x32_bf16(Bt[n][k], At[m][k], acc[ai][bj][m][n], 0, 0, 0); __builtin_amdgcn_s_setprio(0); } while (0)
#define PG8_WAIT_V(n) asm volatile("s_waitcnt vmcnt(" #n ")" ::: "memory")
#define PG8_WAIT_L(n) asm volatile("s_waitcnt lgkmcnt(" #n ")" ::: "memory")
#define PG8_BAR __builtin_amdgcn_s_barrier()
#define PG8_SCHED __builtin_amdgcn_sched_barrier(0)
    Unit cur, nxt; int ui = 0;
    if (!S.next(0, cur)) return;
    f32x4 acc[2][2][4][2];
#pragma unroll
    for (int a = 0; a < 2; ++a)
#pragma unroll
        for (int b = 0; b < 2; ++b)
#pragma unroll
            for (int m = 0; m < 4; ++m)
#pragma unroll
                for (int n = 0; n < 2; ++n) acc[a][b][m][n] = (f32x4){0.f, 0.f, 0.f, 0.f};
    bf16x8 At[4][2], B0[2][2], B1[2][2];
    const char* cA = (const char*)g.A + (size_t)cur.pm * tstep; const char* cB = (const char*)g.Bt + (size_t)cur.pn * tstep;
    S.a_ready(cur);
    if constexpr (SP2) {
        PG8_STAGE(PG8_SB(0, 0), cB, voffB); PG8_STAGE(PG8_SB(0, 1), cB + hstep, voffB); PG8_STAGE(PG8_SA(0, 0), cA, voffA); PG8_STAGE(PG8_SA(0, 1), cA + hstep, voffA);
        if (wr == 1) PG8_BAR;
        PG8_WAIT_V(2); PG8_BAR;
        PG8_STAGE(PG8_SB(1, 0), cB + kstep, voffB); PG8_STAGE(PG8_SA(1, 0), cA + kstep, voffA); PG8_STAGE(PG8_SB(1, 1), cB + hstep + kstep, voffB);
        PG8_WAIT_V(6); PG8_BAR;
    } else {
        PG8_STAGE(PG8_SB(0, 0), cB, voffB); PG8_STAGE(PG8_SA(0, 0), cA, voffA); PG8_STAGE(PG8_SB(0, 1), cB + hstep, voffB); PG8_STAGE(PG8_SA(0, 1), cA + hstep, voffA);
        if (wr == 1) PG8_BAR;
        PG8_WAIT_V(4); PG8_BAR;
        PG8_STAGE(PG8_SB(1, 0), cB + kstep, voffB); PG8_STAGE(PG8_SA(1, 0), cA + kstep, voffA); PG8_STAGE(PG8_SB(1, 1), cB + hstep + kstep, voffB);
        PG8_WAIT_V(6); PG8_BAR;
    }
    for (;;) {
        const bool has_next = S.next(ui + 1, nxt);
        const char* nA = has_next ? (const char*)g.A + (size_t)nxt.pm * tstep : cA; const char* nB = has_next ? (const char*)g.Bt + (size_t)nxt.pn * tstep : cB;
        for (int t = 0; t < nt; t += 2) {
            const bool last = (t == nt - 2);
            const char* a1 = cA + (size_t)(t + 1) * kstep;
            const char* a2 = last ? nA : cA + (size_t)(t + 2) * kstep; const char* b2 = last ? nB : cB + (size_t)(t + 2) * kstep;
            const char* a3 = a2 + kstep; const char* b3 = b2 + kstep;
            if (last && has_next) S.a_ready(nxt);
            if constexpr (SP2) {
            PG8_LDB(B0, 0, 0); PG8_LDB(B1, 0, 1); PG8_SCHED; PG8_LDA(At, 0, 0); PG8_STAGE(PG8_SA(1, 1), a1 + hstep, voffA);
            PG8_WAIT_V(8); PG8_WAIT_L(0); PG8_BAR; PG8_MMA(0, 0, At, B0); PG8_MMA(0, 1, At, B1); PG8_BAR; PG8_SCHED;
            PG8_LDA(At, 0, 1); PG8_STAGE(PG8_SB(0, 0), b2, voffB); PG8_STAGE(PG8_SB(0, 1), b2 + hstep, voffB); PG8_STAGE(PG8_SA(0, 0), a2, voffA);
            PG8_WAIT_V(8); PG8_WAIT_L(0); PG8_BAR; PG8_MMA(1, 0, At, B0); PG8_MMA(1, 1, At, B1); PG8_BAR; PG8_SCHED;
            PG8_LDB(B0, 1, 0); PG8_LDB(B1, 1, 1); PG8_SCHED; PG8_LDA(At, 1, 0); PG8_STAGE(PG8_SA(0, 1), a2 + hstep, voffA);
            PG8_WAIT_V(8); PG8_WAIT_L(0); PG8_BAR; PG8_MMA(0, 0, At, B0); PG8_MMA(0, 1, At, B1); PG8_BAR; PG8_SCHED;
            PG8_LDA(At, 1, 1); PG8_STAGE(PG8_SB(1, 0), b3, voffB); PG8_STAGE(PG8_SB(1, 1), b3 + hstep, voffB); PG8_STAGE(PG8_SA(1, 0), a3, voffA);
            PG8_WAIT_V(8); PG8_WAIT_L(0); PG8_BAR; PG8_MMA(1, 0, At, B0); PG8_MMA(1, 1, At, B1); PG8_BAR; PG8_SCHED;
            } else {
            PG8_LDB(B0, 0, 0); PG8_SCHED; PG8_LDA(At, 0, 0); PG8_STAGE(PG8_SA(1, 1), a1 + hstep, voffA);
            PG8_WAIT_L(8); PG8_BAR; PG8_WAIT_L(0); PG8_MMA(0, 0, At, B0); PG8_BAR; PG8_SCHED;
            PG8_LDB(B1, 0, 1); PG8_STAGE(PG8_SB(0, 0), b2, voffB);
            PG8_BAR; PG8_WAIT_L(0); PG8_MMA(0, 1, At, B1); PG8_BAR;
            PG8_LDA(At, 0, 1); PG8_STAGE(PG8_SA(0, 0), a2, voffA);
            PG8_BAR; PG8_WAIT_L(0); PG8_MMA(1, 0, At, B0); PG8_BAR; PG8_SCHED;
            PG8_STAGE(PG8_SB(0, 1), b2 + hstep, voffB);
            PG8_WAIT_V(6); PG8_BAR; PG8_MMA(1, 1, At, B1); PG8_BAR;
            PG8_LDB(B0, 1, 0); PG8_SCHED; PG8_LDA(At, 1, 0); PG8_STAGE(PG8_SA(0, 1), a2 + hstep, voffA);
            PG8_WAIT_L(8); PG8_BAR; PG8_WAIT_L(0); PG8_MMA(0, 0, At, B0); PG8_BAR; PG8_SCHED;
            PG8_LDB(B1, 1, 1); PG8_STAGE(PG8_SB(1, 0), b3, voffB);
            PG8_BAR; PG8_WAIT_L(0); PG8_MMA(0, 1, At, B1); PG8_BAR;
            PG8_LDA(At, 1, 1); PG8_STAGE(PG8_SA(1, 0), a3, voffA);
            PG8_BAR; PG8_WAIT_L(0); PG8_MMA(1, 0, At, B0); PG8_BAR; PG8_SCHED;
            PG8_STAGE(PG8_SB(1, 1), b3 + hstep, voffB);
            PG8_WAIT_V(6); PG8_BAR; PG8_MMA(1, 1, At, B1); PG8_BAR;
            }
        }
        if constexpr (ALIGN_EPI) { if (wr == 0) PG8_BAR; }
        if constexpr (!Epi::AFTER_DRAIN) { E(acc, cur, wr, wc, fr, fq); S.done(cur); }
        if (!has_next) break;
#pragma unroll
        for (int a = 0; a < 2; ++a)
#pragma unroll
            for (int b = 0; b < 2; ++b)
#pragma unroll
                for (int m = 0; m < 4; ++m)
#pragma unroll
                    for (int n = 0; n < 2; ++n) acc[a][b][m][n] = (f32x4){0.f, 0.f, 0.f, 0.f};
        cur = nxt; cA = nA; cB = nB; ++ui;
        if constexpr (ALIGN_EPI) { if (wr == 1) PG8_BAR; }
    }
    PG8_WAIT_V(0);
    if constexpr (!ALIGN_EPI) { if (wr == 0) PG8_BAR; }
    PG8_BAR;
    if constexpr (Epi::AFTER_DRAIN) { E.fused(acc, cur, wr, wc, fr, fq, lds, wid, lane); S.done(cur); }
#undef PG8_SA
#undef PG8_SB
#undef PG8_STAGE
#undef PG8_LDA
#undef PG8_LDB
#undef PG8_MMA
#undef PG8_WAIT_V
#undef PG8_WAIT_L
#undef PG8_BAR
#undef PG8_SCHED
}
}

#ifndef MK_ONE_LAUNCH
#define MK_ONE_LAUNCH 1
#endif
#define LAS __attribute__((address_space(3)))
typedef unsigned short bf16;
typedef float f32x4 __attribute__((ext_vector_type(4)));

constexpr int DM = 1024, NBATCH = 16, SEQ = 2048, M = NBATCH * SEQ, DEPTH = 4;
constexpr int NPROJ = 3072, FFN = 2816, NUP = 5632, INC = 2832;
constexpr int PQ = 0, PK = 192, PV = 384, PR = 768, PG = 1152, PBG = 1344, PBI = 1600, PCQ = 1856, PCK = 2240, PCV = 2624;
constexpr int OA = 0, OB = 384, OC = 640;
constexpr float EPS = 1e-6f;

constexpr size_t MiB = 1u << 20;
constexpr size_t WS_CTL = 0, CTL_ZERO_BYTES = 163840;
constexpr size_t WS_COS = 1 * MiB, WS_SIN = WS_COS + 65536;
constexpr size_t WS_W0 = 2 * MiB, WS_W1 = 480 * MiB;
constexpr size_t WO_IN = 0, WO_OUT = 6 * MiB, WO_UP = 8 * MiB, WO_DN = 19 * MiB, WO_LRUW = 24 * MiB + 512 * 1024, WO_LRUSP = WO_LRUW + 65536, WSET_BYTES = 25 * MiB;
constexpr size_t WS_XB = 28 * MiB, WS_PROJ = 92 * MiB, WS_ACT = 92 * MiB, WS_MIX = 284 * MiB;
constexpr size_t WS_SS = 28 * MiB;
constexpr size_t WS_PRE = 348 * MiB, WS_RAW = 354 * MiB;
constexpr size_t WS_OP = 348 * MiB, WS_LSE = 420 * MiB, WS_HIN = 423 * MiB, WS_SSP = 426 * MiB;
constexpr size_t WS_US = 436 * MiB, WS_DB = 472 * MiB, WS_PB = 473 * MiB, WS_QB = 475 * MiB, WS_END = 512 * MiB;
static_assert(WS_W0 + WSET_BYTES <= WS_XB && WS_W1 + WSET_BYTES <= WS_END && WO_DN + (size_t)DM * FFN * 2 <= WO_LRUW && WS_OP + (size_t)3 * M * 384 * 2 <= WS_LSE && WS_US + (size_t)4096 * 96 * 48 * 2 <= WS_DB, "ws map");
constexpr int CW_BAR = 4096, CW_WDONE = 1024;

constexpr int RING_BYTES = 131072, MISC_OFF = RING_BYTES + 320, HALO_OFF = RING_BYTES + 1024, LDS_BYTES = 147456;

constexpr int PPL = 7;
constexpr int P_PRO = 0, P_FIN = 1 + DEPTH * PPL, NPH = P_FIN + 1;
enum { L_INPROJ = 0, L_MA, L_MB, L_MC, L_OUTPROJ, L_UP, L_DOWN };
static_assert(L_DOWN == PPL - 1, "phase ids");

#define XB_TMO      128
#define XB_XCNT(j)  (256  + 64 * (j))
#define XB_XSUB(j)  (1280 + 64 * (j))
#define XB_XGEN(j)  (2304 + 64 * (j))
#define XB_TOP      3328
#define XB_TOPGEN   3392
#define XCD_BAR_WORDS 3456
#define XB_SPIN_CAP (1u << 18)

__device__ __forceinline__ unsigned xb_ld(unsigned* p)              { return __hip_atomic_load(p, __ATOMIC_RELAXED, __HIP_MEMORY_SCOPE_AGENT); }
__device__ __forceinline__ unsigned xb_add(unsigned* p, unsigned v) { return __hip_atomic_fetch_add(p, v, __ATOMIC_RELAXED, __HIP_MEMORY_SCOPE_AGENT); }
__device__ __forceinline__ unsigned xb_xcc_id() { return (unsigned)__builtin_amdgcn_s_getreg((3 << 11) | 20) & 0xFu; }
#define XB_SPIN(cond, bar) do { unsigned _sp = 0; while (cond) { __builtin_amdgcn_s_sleep(1); \
    if ((++_sp & 255u) == 0u) { if (xb_ld(&(bar)[XB_TMO])) break; if (_sp > XB_SPIN_CAP) { atomicAdd(&(bar)[XB_TMO], 1u); break; } } } } while (0)

struct XcdBarrier {
    unsigned* bar; unsigned x, ng;
    volatile LAS unsigned* st;
};

__device__ __forceinline__ XcdBarrier xcd_barrier_post(unsigned* bar, volatile LAS unsigned* st, unsigned ng) {
    XcdBarrier b; b.bar = bar; b.x = xb_xcc_id(); b.st = st; b.ng = ng;
    if (threadIdx.x == 0) (void)xb_add(&bar[XB_XCNT(b.x)], 1u);
    return b;
}
__device__ __forceinline__ void xcd_barrier_complete(unsigned* bar, unsigned x, unsigned& nloc, unsigned& nx, const unsigned G  ) {
    unsigned sum, cnt, mine, sp = 0u;
    for (;;) {
        sum = 0u; cnt = 0u; mine = 0u;
#pragma unroll
        for (unsigned j = 0; j < 16; ++j) { const unsigned c = xb_ld(&bar[XB_XCNT(j)]); sum += c; cnt += (c > 0u) ? 1u : 0u; mine = (j == x) ? c : mine; }
        if (sum == G) break;
        __builtin_amdgcn_s_sleep(1);
        if ((++sp & 255u) == 0u) { if (xb_ld(&bar[XB_TMO])) break; if (sp > XB_SPIN_CAP) { atomicAdd(&bar[XB_TMO], 1u); break; } }
    }
    nloc = mine > 0u ? mine : 1u; nx = cnt > 0u ? cnt : 1u;
}

__device__ __forceinline__ void xcd_barrier(const XcdBarrier& b) {
    asm volatile("s_waitcnt vmcnt(0)" ::: "memory");
    __syncthreads();
    if (threadIdx.x == 0) {
        unsigned* bar = b.bar;
        __builtin_amdgcn_s_waitcnt(0);
        unsigned nloc = b.st[0], nx = b.st[1];
        if (nloc == 0u) { xcd_barrier_complete(bar, b.x, nloc, nx, b.ng); b.st[0] = nloc; b.st[1] = nx; }
        const unsigned old = xb_add(&bar[XB_XSUB(b.x)], 1u);
        const unsigned gen = old / nloc;
        if (old + 1u == (gen + 1u) * nloc) {
            __builtin_amdgcn_fence(__ATOMIC_RELEASE, "agent");
            asm volatile("s_waitcnt vmcnt(0)" ::: "memory");
            const unsigned og = xb_add(&bar[XB_TOP], 1u);
            const unsigned tg = og / nx;
            if (og + 1u == (tg + 1u) * nx) xb_add(&bar[XB_TOPGEN], 1u);
            else XB_SPIN(xb_ld(&bar[XB_TOPGEN]) == tg, bar);
            __builtin_amdgcn_fence(__ATOMIC_ACQUIRE, "agent");
            xb_add(&bar[XB_XGEN(b.x)], 1u);
            asm volatile("s_waitcnt vmcnt(0)" ::: "memory");
        } else {
            XB_SPIN(xb_ld(&bar[XB_XGEN(b.x)]) == gen, bar);
            __builtin_amdgcn_fence(__ATOMIC_ACQUIRE, "agent");
            asm volatile("s_waitcnt vmcnt(0)" ::: "memory");
        }
    }
    __syncthreads();
}


__device__ __forceinline__ float bf2f(bf16 b) { return __uint_as_float((unsigned)b << 16); }
__device__ __forceinline__ bf16 f2bf(float f) { const unsigned u = __float_as_uint(f); return (bf16)((u + 0x7fffu + ((u >> 16) & 1u)) >> 16); }
__device__ __forceinline__ unsigned pk2(float lo, float hi) { return (unsigned)f2bf(lo) | ((unsigned)f2bf(hi) << 16); }
__device__ __forceinline__ float wave_sum(float v) {
#pragma unroll
    for (int o = 1; o < 64; o <<= 1) v += __shfl_xor(v, o);
    return v;
}
__device__ __forceinline__ float sigmoidf_(float x) { return 1.f / (1.f + __expf(-x)); }
__device__ __forceinline__ float gelu_tanh(float x) { const float u = 0.7978845608028654f * (x + 0.044715f * x * x * x); const float t = 1.f - 2.f / (1.f + __expf(2.f * u)); return 0.5f * x * (1.f + t); }
__device__ __forceinline__ float softplusf_(float x) { return fmaxf(x, 0.f) + log1pf(__expf(-fabsf(x))); }

__device__ __forceinline__ void convert_layer_weights(int l, unsigned char* ws, int gtid_, int gsz_, const float* norm_mix_, const float* w_in_, const float* gla_w_gate_, const float* w_out_, const float* norm_ffn_, const float* ffn_w_up_,
                                                      const float* ffn_w_down_, const float* lru_w_a_, const float* lru_w_x_, const float* lru_lambda_) {
    bf16* Win_t = (bf16*)(ws + WO_IN); bf16* Wout_t = (bf16*)(ws + WO_OUT); bf16* Wup_t = (bf16*)(ws + WO_UP); bf16* Wdn_t = (bf16*)(ws + WO_DN); uint4* LRUW = (uint4*)(ws + WO_LRUW); float* LRUSP = (float*)(ws + WO_LRUSP);
    const float* wl = w_in_ + (size_t)l * DM * INC; const float* gm = norm_mix_ + l * DM; const float* wg = gla_w_gate_ + (size_t)l * 16 * 192;
    for (int it = gtid_; it < NPROJ * (DM / 8); it += gsz_) {
        const int n = it % NPROJ, k0 = (it / NPROJ) * 8; float v[8];
        if (n >= PG && n < PBG) { const int c = n - PG;
#pragma unroll
            for (int kk = 0; kk < 8; ++kk) { const float* wr_ = wl + (size_t)(k0 + kk) * INC + 1152; float s = 0.f;
#pragma unroll
                for (int j = 0; j < 16; ++j) s += wr_[j] * wg[j * 192 + c];
                v[kk] = s * gm[k0 + kk]; }
        } else if (n < 3008) { const int src = (n < PG) ? n : n - 176; const float sc = (n < PK) ? 0.14433756729740643f : ((n >= PCQ && n < PCK) ? 0.18033688011112042f   : 1.f);
#pragma unroll
            for (int kk = 0; kk < 8; ++kk) v[kk] = wl[(size_t)(k0 + kk) * INC + src] * gm[k0 + kk] * sc;
        } else {
#pragma unroll
            for (int kk = 0; kk < 8; ++kk) v[kk] = 0.f;
        }
        *(uint4*)(Win_t + (size_t)n * DM + k0) = make_uint4(pk2(v[0], v[1]), pk2(v[2], v[3]), pk2(v[4], v[5]), pk2(v[6], v[7]));
    }
    const float* wo = w_out_ + (size_t)l * DM * DM;
    for (int it = gtid_; it < DM * (DM / 8); it += gsz_) { const int n = it % DM, k0 = (it / DM) * 8; float v[8];
#pragma unroll
        for (int kk = 0; kk < 8; ++kk) v[kk] = wo[(size_t)(k0 + kk) * DM + n];
        *(uint4*)(Wout_t + (size_t)n * DM + k0) = make_uint4(pk2(v[0], v[1]), pk2(v[2], v[3]), pk2(v[4], v[5]), pk2(v[6], v[7])); }
    const float* wu = ffn_w_up_ + (size_t)l * DM * NUP; const float* gf = norm_ffn_ + l * DM;
    for (int it = gtid_; it < NUP * (DM / 8); it += gsz_) { const int n = it % NUP, k0 = (it / NUP) * 8; float v[8]; const int src = ((n >> 7) & 1) * FFN + (n >> 8) * 128 + (n & 127);
#pragma unroll
        for (int kk = 0; kk < 8; ++kk) v[kk] = wu[(size_t)(k0 + kk) * NUP + src] * gf[k0 + kk];
        *(uint4*)(Wup_t + (size_t)n * DM + k0) = make_uint4(pk2(v[0], v[1]), pk2(v[2], v[3]), pk2(v[4], v[5]), pk2(v[6], v[7])); }
    const float* wd = ffn_w_down_ + (size_t)l * FFN * DM;
    for (int it = gtid_; it < DM * (FFN / 8); it += gsz_) { const int n = it % DM, k0 = (it / DM) * 8; float v[8];
#pragma unroll
        for (int kk = 0; kk < 8; ++kk) v[kk] = wd[(size_t)(k0 + kk) * DM + n];
        *(uint4*)(Wdn_t + (size_t)n * FFN + k0) = make_uint4(pk2(v[0], v[1]), pk2(v[2], v[3]), pk2(v[4], v[5]), pk2(v[6], v[7])); }
    for (int it = gtid_; it < 2 * 8 * 2 * 64; it += gsz_) { const int ln_ = it & 63, hf = (it >> 6) & 1, n = (it >> 7) & 7, g = it >> 10, fr = ln_ & 15, q = ln_ >> 4;
        const float* Wg = (g ? lru_w_x_ : lru_w_a_) + (size_t)(l * 8 + n) * 1024; float v[8];
#pragma unroll
        for (int e = 0; e < 8; ++e) v[e] = Wg[(8 * q + e) * 32 + 16 * hf + fr];
        LRUW[it] = make_uint4(pk2(v[0], v[1]), pk2(v[2], v[3]), pk2(v[4], v[5]), pk2(v[6], v[7])); }
    for (int c = gtid_; c < 256; c += gsz_) LRUSP[c] = softplusf_(-lru_lambda_[l * 256 + c]);
}


typedef short bf16x8v __attribute__((ext_vector_type(8)));
typedef float f32x16 __attribute__((ext_vector_type(16)));
typedef unsigned u32x4v __attribute__((ext_vector_type(4)));
typedef float f32x2_t __attribute__((ext_vector_type(2)));
typedef __bf16 bf16x2_t __attribute__((ext_vector_type(2)));
__device__ __forceinline__ unsigned cvtpk(float lo, float hi) { f32x2_t v = {lo, hi}; bf16x2_t b = __builtin_convertvector(v, bf16x2_t); return __builtin_bit_cast(unsigned, b); }
__device__ __forceinline__ void unpack8(const uint4 u, float (&f)[8]) {
    f[0] = __uint_as_float(u.x << 16); f[1] = __uint_as_float(u.x & 0xffff0000u); f[2] = __uint_as_float(u.y << 16); f[3] = __uint_as_float(u.y & 0xffff0000u);
    f[4] = __uint_as_float(u.z << 16); f[5] = __uint_as_float(u.z & 0xffff0000u); f[6] = __uint_as_float(u.w << 16); f[7] = __uint_as_float(u.w & 0xffff0000u); }
__device__ __forceinline__ bf16x8v pack8(const float (&f)[8]) {
    u32x4v w; w.x = cvtpk(f[0], f[1]); w.y = cvtpk(f[2], f[3]); w.z = cvtpk(f[4], f[5]); w.w = cvtpk(f[6], f[7]); return __builtin_bit_cast(bf16x8v, w); }
__device__ __forceinline__ bf16x8v pack8v(const f32x16& p, int o) {
    u32x4v w; w.x = cvtpk(p[o + 0], p[o + 1]); w.y = cvtpk(p[o + 2], p[o + 3]); w.z = cvtpk(p[o + 4], p[o + 5]); w.w = cvtpk(p[o + 6], p[o + 7]); return __builtin_bit_cast(bf16x8v, w); }
#define MFMA32(a, b, c) __builtin_amdgcn_mfma_f32_32x32x16_bf16((a), (b), (c), 0, 0, 0)

__device__ __forceinline__ void gla_scan(const uint4 (&gp)[3], const float* __restrict__ bgate  , int hh, int r, float (&bv)[3][8]) {
#pragma unroll
    for (int s = 0; s < 3; ++s) { float x[8]; unpack8(gp[s], x);
#pragma unroll
        for (int e = 0; e < 8; ++e) { const float xx = x[e] + bgate[16 * s + 8 * hh + e]; bv[s][e] = (fminf(xx, 0.f) - __logf(1.f + __expf(-fabsf(xx)))) * 0.0625f; } }
#pragma unroll
    for (int s = 0; s < 3; ++s)
#pragma unroll
        for (int e = 0; e < 8; ++e) { float v = bv[s][e];
            v += __builtin_bit_cast(float, __builtin_amdgcn_mov_dpp(__builtin_bit_cast(int, v), 0x111, 0xf, 0xf, true));
            v += __builtin_bit_cast(float, __builtin_amdgcn_mov_dpp(__builtin_bit_cast(int, v), 0x112, 0xf, 0xf, true));
            v += __builtin_bit_cast(float, __builtin_amdgcn_mov_dpp(__builtin_bit_cast(int, v), 0x114, 0xf, 0xf, true));
            v += __builtin_bit_cast(float, __builtin_amdgcn_mov_dpp(__builtin_bit_cast(int, v), 0x118, 0xf, 0xf, true));
            v += __builtin_bit_cast(float, __builtin_amdgcn_update_dpp(0, __builtin_bit_cast(int, v), 0x142, 0xa, 0xf, false));
            bv[s][e] = v; }
    (void)r;
}
__device__ __forceinline__ void gla_vload(const bf16* __restrict__ vbase  , int hh, unsigned (&w)[3][2][4]) {
#pragma unroll
    for (int dt = 0; dt < 3; ++dt)
#pragma unroll
        for (int sp = 0; sp < 2; ++sp)
#pragma unroll
            for (int j2 = 0; j2 < 4; ++j2) { const int j = 2 * j2; const int t0 = 16 * sp + 8 * (j >> 2) + 4 * hh + (j & 3);
                w[dt][sp][j2] = (unsigned)vbase[(size_t)t0 * NPROJ + 32 * dt] | ((unsigned)vbase[(size_t)(t0 + 1) * NPROJ + 32 * dt] << 16); }
}
__device__ __forceinline__ bf16x8v gla_vf(const unsigned (&w)[4]) { u32x4v v; v.x = w[0]; v.y = w[1]; v.z = w[2]; v.w = w[3]; return __builtin_bit_cast(bf16x8v, v); }
__device__ __forceinline__ void gla_m1_unit(int unit, int l, int lane_, const bf16* __restrict__ PROJ_, const float* __restrict__ gla_b_gate_, bf16* __restrict__ US_, float* __restrict__ DB_) {
    const int n = unit & 63, bh = unit >> 6, h = bh & 3, b = bh >> 2, r = lane_ & 31, hh = lane_ >> 5;
    const size_t row0 = (size_t)b * SEQ + n * 32;
    const bf16* prow = PROJ_ + (row0 + r) * NPROJ;
    uint4 gp[3], gk[3]; unsigned vw[3][2][4];
#pragma unroll
    for (int s = 0; s < 3; ++s) { gp[s] = *(const uint4*)(prow + PG + h * 48 + 16 * s + 8 * hh); gk[s] = *(const uint4*)(prow + PK + h * 48 + 16 * s + 8 * hh); }
    gla_vload(PROJ_ + row0 * NPROJ + PV + h * 96 + r, hh, vw);
    float bv[3][8]; gla_scan(gp, gla_b_gate_ + l * 192 + h * 48, hh, r, bv);
    bf16x8v kd[3];
#pragma unroll
    for (int s = 0; s < 3; ++s) { float x[8]; unpack8(gk[s], x);
#pragma unroll
        for (int e = 0; e < 8; ++e) { const float bl = __shfl(bv[s][e], 31, 32); x[e] *= __expf(bl - bv[s][e]); }
        kd[s] = pack8(x); }
    if (r == 31) {
#pragma unroll
        for (int s = 0; s < 3; ++s)
#pragma unroll
            for (int e = 0; e < 8; ++e) DB_[(size_t)unit * 48 + 16 * s + 8 * hh + e] = __expf(bv[s][e]); }
    bf16x8v I00, I10, I21;
#pragma unroll
    for (int e = 0; e < 8; ++e) { I00[e] = (8 * hh + e == r) ? (short)0x3F80 : (short)0; I10[e] = (16 + 8 * hh + e == r) ? (short)0x3F80 : (short)0; I21[e] = (8 * hh + e == r) ? (short)0x3F80 : (short)0; }
    f32x16 X0, X1;
#pragma unroll
    for (int i = 0; i < 16; ++i) { X0[i] = 0.f; X1[i] = 0.f; }
    X0 = MFMA32(kd[0], I00, X0); X0 = MFMA32(kd[1], I10, X0); X1 = MFMA32(kd[2], I21, X1);
    const bf16x8v xa00 = pack8v(X0, 0), xa01 = pack8v(X0, 8), xa10 = pack8v(X1, 0), xa11 = pack8v(X1, 8);
    bf16* ub = US_ + (size_t)unit * 96 * 48;
#pragma unroll
    for (int dt = 0; dt < 3; ++dt) { const bf16x8v v0 = gla_vf(vw[dt][0]), v1 = gla_vf(vw[dt][1]);
        f32x16 A0, A1;
#pragma unroll
        for (int i = 0; i < 16; ++i) { A0[i] = 0.f; A1[i] = 0.f; }
        A0 = MFMA32(xa00, v0, A0); A0 = MFMA32(xa01, v1, A0); A1 = MFMA32(xa10, v0, A1); A1 = MFMA32(xa11, v1, A1);
        bf16* up = ub + (size_t)(32 * dt + r) * 48;
#pragma unroll
        for (int qd = 0; qd < 4; ++qd) { pg8::u32x2 w; w.x = cvtpk(A0[4 * qd], A0[4 * qd + 1]); w.y = cvtpk(A0[4 * qd + 2], A0[4 * qd + 3]); *(pg8::u32x2*)(up + 8 * qd + 4 * hh) = w; }
#pragma unroll
        for (int qd = 0; qd < 2; ++qd) { pg8::u32x2 w; w.x = cvtpk(A1[4 * qd], A1[4 * qd + 1]); w.y = cvtpk(A1[4 * qd + 2], A1[4 * qd + 3]); *(pg8::u32x2*)(up + 32 + 8 * qd + 4 * hh) = w; }
    }
}
__device__ __forceinline__ void gla_m2_item(int item, const bf16* __restrict__ US_, bf16* __restrict__ SS_, const float* __restrict__ DB_) {
    const int c8 = item % 6, dv = (item / 6) % 96, bh = item / 576;
    float S[8];
#pragma unroll
    for (int e = 0; e < 8; ++e) S[e] = 0.f;
#pragma unroll 16
    for (int n = 0; n < 64; ++n) { const size_t unit = (size_t)bh * 64 + n; const uint4* p = (const uint4*)(US_ + (unit * 96 + dv) * 48 + c8 * 8); uint4* po = (uint4*)(SS_ + (unit * 96 + dv) * 48 + c8 * 8); const float4* dp = (const float4*)(DB_ + unit * 48 + c8 * 8);
        const uint4 u = *p; const float4 d0 = dp[0], d1 = dp[1]; float x[8]; unpack8(u, x);
        *po = make_uint4(cvtpk(S[0], S[1]), cvtpk(S[2], S[3]), cvtpk(S[4], S[5]), cvtpk(S[6], S[7]));
        S[0] = d0.x * S[0] + x[0]; S[1] = d0.y * S[1] + x[1]; S[2] = d0.z * S[2] + x[2]; S[3] = d0.w * S[3] + x[3];
        S[4] = d1.x * S[4] + x[4]; S[5] = d1.y * S[5] + x[5]; S[6] = d1.z * S[6] + x[6]; S[7] = d1.w * S[7] + x[7]; }
}
__device__ __forceinline__ void gla_m3_unit(int unit, int l, int lane_, const bf16* __restrict__ PROJ_, const float* __restrict__ gla_b_gate_, const float* __restrict__ gla_norm_, const bf16* __restrict__ SS_, bf16* __restrict__ MIX_) {
    const int n = unit & 63, bh = unit >> 6, h = bh & 3, b = bh >> 2, r = lane_ & 31, hh = lane_ >> 5;
    const size_t row0 = (size_t)b * SEQ + n * 32;
    const bf16* prow = PROJ_ + (row0 + r) * NPROJ;
    uint4 gp[3], gq[3], gk[3]; unsigned vw[3][2][4]; bf16x8v sf[3][3]; unsigned short rg[16][3];
#pragma unroll
    for (int s = 0; s < 3; ++s) { gp[s] = *(const uint4*)(prow + PG + h * 48 + 16 * s + 8 * hh); gq[s] = *(const uint4*)(prow + PQ + h * 48 + 16 * s + 8 * hh); gk[s] = *(const uint4*)(prow + PK + h * 48 + 16 * s + 8 * hh); }
    gla_vload(PROJ_ + row0 * NPROJ + PV + h * 96 + r, hh, vw);
    const bf16* ub = SS_ + (size_t)unit * 96 * 48;
#pragma unroll
    for (int dt = 0; dt < 3; ++dt)
#pragma unroll
        for (int s = 0; s < 3; ++s) sf[dt][s] = *(const bf16x8v*)(ub + (size_t)(32 * dt + r) * 48 + 16 * s + 8 * hh);
#pragma unroll
    for (int i = 0; i < 16; ++i) { const int ti = (i & 3) + 8 * (i >> 2) + 4 * hh;
#pragma unroll
        for (int dt = 0; dt < 3; ++dt) rg[i][dt] = PROJ_[(row0 + ti) * NPROJ + PR + h * 96 + 32 * dt + r]; }
    float bv[3][8]; gla_scan(gp, gla_b_gate_ + l * 192 + h * 48, hh, r, bv);
    bf16x8v qt[3], kt[3];
#pragma unroll
    for (int s = 0; s < 3; ++s) { float xq[8], xk[8]; unpack8(gq[s], xq); unpack8(gk[s], xk);
#pragma unroll
        for (int e = 0; e < 8; ++e) { const float eb = __expf(bv[s][e]); xq[e] *= eb; xk[e] *= __builtin_amdgcn_rcpf(eb); }
        qt[s] = pack8(xq); kt[s] = pack8(xk); }
    f32x16 P;
#pragma unroll
    for (int i = 0; i < 16; ++i) P[i] = 0.f;
#pragma unroll
    for (int s = 0; s < 3; ++s) P = MFMA32(kt[s], qt[s], P);
#pragma unroll
    for (int i = 0; i < 16; ++i) { const int j = (i & 3) + 8 * (i >> 2) + 4 * hh; if (j > r) P[i] = 0.f; }
    const bf16x8v p0 = pack8v(P, 0), p1 = pack8v(P, 8);
    f32x16 O[3];
#pragma unroll
    for (int dt = 0; dt < 3; ++dt) {
#pragma unroll
        for (int i = 0; i < 16; ++i) O[dt][i] = 0.f;
        O[dt] = MFMA32(p0, gla_vf(vw[dt][0]), O[dt]); O[dt] = MFMA32(p1, gla_vf(vw[dt][1]), O[dt]);
#pragma unroll
        for (int s = 0; s < 3; ++s) O[dt] = MFMA32(qt[s], sf[dt][s], O[dt]);
    }
    const float* gn = gla_norm_ + l * 96; const float g0 = gn[r], g1 = gn[32 + r], g2 = gn[64 + r];
    bf16* mix0 = MIX_ + (row0 + 4 * hh) * DM + OA + h * 96 + r;
#pragma unroll
    for (int i = 0; i < 16; ++i) { float ss = O[0][i] * O[0][i] + O[1][i] * O[1][i] + O[2][i] * O[2][i];
        ss += __builtin_bit_cast(float, __builtin_amdgcn_mov_dpp(__builtin_bit_cast(int, ss), 0x128, 0xf, 0xf, true));
        ss += __builtin_bit_cast(float, __builtin_amdgcn_mov_dpp(__builtin_bit_cast(int, ss), 0x124, 0xf, 0xf, true));
        ss += __builtin_bit_cast(float, __builtin_amdgcn_mov_dpp(__builtin_bit_cast(int, ss), 0x122, 0xf, 0xf, true));
        ss += __builtin_bit_cast(float, __builtin_amdgcn_mov_dpp(__builtin_bit_cast(int, ss), 0x121, 0xf, 0xf, true));
        ss += __shfl_xor(ss, 16);
        const float rs = __builtin_amdgcn_rsqf(ss * (1.f / 96.f) + EPS);
        float ov[3];
#pragma unroll
        for (int dt = 0; dt < 3; ++dt) { const float rr = bf2f(rg[i][dt]); const float gnv = dt == 0 ? g0 : (dt == 1 ? g1 : g2); ov[dt] = O[dt][i] * rs * gnv * rr * __builtin_amdgcn_rcpf(1.f + __expf(-rr)); }
        bf16* mp = mix0 + (size_t)((i & 3) + 8 * (i >> 2)) * DM; const unsigned w01 = cvtpk(ov[0], ov[1]), w2 = cvtpk(ov[2], ov[2]);
        mp[0] = (bf16)w01; mp[32] = (bf16)(w01 >> 16); mp[64] = (bf16)w2; }
}

typedef float f32x4v __attribute__((ext_vector_type(4)));
#define MFMA16(a, b, c) __builtin_amdgcn_mfma_f32_16x16x32_bf16((a), (b), (c), 0, 0, 0)

__device__ __forceinline__ void lru_tile_block(const bf16* PROJ_, size_t row0, int t0, int n, int lane_, const float* cw  , const float* cb, const uint4* lruw, const float* ba, const float* bx, const float* sp,
                                               float (&av)[2][4], float (&uv)[2][4]) {
    const int fr = lane_ & 15, q = lane_ >> 4, t = t0 + fr, cbase = 32 * n + 8 * q;
    float y[8];
    { const float4 b0 = *(const float4*)(cb + cbase), b1 = *(const float4*)(cb + cbase + 4); y[0] = b0.x; y[1] = b0.y; y[2] = b0.z; y[3] = b0.w; y[4] = b1.x; y[5] = b1.y; y[6] = b1.z; y[7] = b1.w; }
#pragma unroll
    for (int k = 0; k < 4; ++k) if (t - 3 + k >= 0) { const uint4 u = *(const uint4*)(PROJ_ + (row0 + fr - 3 + k) * NPROJ + PBI + cbase); float x[8]; unpack8(u, x);
        const float4 w0 = *(const float4*)(cw + k * 256 + cbase), w1 = *(const float4*)(cw + k * 256 + cbase + 4);
        y[0] += w0.x * x[0]; y[1] += w0.y * x[1]; y[2] += w0.z * x[2]; y[3] += w0.w * x[3]; y[4] += w1.x * x[4]; y[5] += w1.y * x[5]; y[6] += w1.z * x[6]; y[7] += w1.w * x[7]; }
    const bf16x8v uA = pack8(y);
#pragma unroll
    for (int hf = 0; hf < 2; ++hf) {
        const bf16x8v Wa = __builtin_bit_cast(bf16x8v, lruw[((0 * 8 + n) * 2 + hf) * 64 + lane_]), Wx = __builtin_bit_cast(bf16x8v, lruw[((1 * 8 + n) * 2 + hf) * 64 + lane_]);
        bf16x8v I;
#pragma unroll
        for (int e = 0; e < 8; ++e) I[e] = (8 * q + e == 16 * hf + fr) ? (short)0x3F80 : (short)0;
        const f32x4v z = {0.f, 0.f, 0.f, 0.f};
        const f32x4v rr = MFMA16(uA, Wa, z), ii = MFMA16(uA, Wx, z), xx = MFMA16(uA, I, z);
        const int c = 32 * n + 16 * hf + fr; const float bac = ba[c], bxc = bx[c], spc = sp[c];
#pragma unroll
        for (int g = 0; g < 4; ++g) { const float r = __builtin_amdgcn_rcpf(1.f + __expf(-(rr[g] + bac))), ig = __builtin_amdgcn_rcpf(1.f + __expf(-(ii[g] + bxc))), la = -8.f * r * spc;
            const float a_ = __expf(la); av[hf][g] = a_; uv[hf][g] = __builtin_amdgcn_sqrtf(fmaxf(1.f - a_ * a_, 0.f)) * ig * xx[g]; }
    }
}
__device__ __forceinline__ void lru_m1_unit(int unit, int l, int lane_, const bf16* PROJ_, const float* lru_conv_w_, const float* lru_conv_b_, const uint4* lruw, const float* lru_b_a_, const float* lru_b_x_, const float* sp, float* PB_, float* QB_) {
    const int tt = unit & 127, b = unit >> 7, fr = lane_ & 15, q = lane_ >> 4;
    const size_t row0 = (size_t)b * SEQ + tt * 16;
#pragma unroll 1
    for (int n = 0; n < 8; ++n) { float av[2][4], uv[2][4];
        lru_tile_block(PROJ_, row0, tt * 16, n, lane_, lru_conv_w_ + l * 1024, lru_conv_b_ + l * 256, lruw, lru_b_a_ + l * 256, lru_b_x_ + l * 256, sp, av, uv);
#pragma unroll
        for (int hf = 0; hf < 2; ++hf) { const float A = av[hf][0] * av[hf][1] * av[hf][2] * av[hf][3], B = ((uv[hf][0] * av[hf][1] + uv[hf][1]) * av[hf][2] + uv[hf][2]) * av[hf][3] + uv[hf][3];
            float At = 1.f, Bt = 0.f;
#pragma unroll
            for (int g = 0; g < 4; ++g) { const float Ag = __shfl(A, fr + 16 * g), Bg = __shfl(B, fr + 16 * g); Bt = Ag * Bt + Bg; At = Ag * At; }
            if (q == 0) { const size_t o = (size_t)unit * 256 + 32 * n + 16 * hf + fr; PB_[o] = At; QB_[o] = Bt; } }
    }
}
__device__ __forceinline__ void lru_m2_item(int item, const float* PB_, const float* QB_, float* HIN_) {
    const int c = item & 255, b = item >> 8; float h = 0.f;
#pragma unroll 32
    for (int tt = 0; tt < 128; ++tt) { const size_t o = ((size_t)b * 128 + tt) * 256 + c; const float p = PB_[o], qv = QB_[o]; HIN_[o] = h; h = p * h + qv; }
}
__device__ __forceinline__ void lru_m3_unit(int unit, int l, int lane_, const bf16* PROJ_, const float* lru_conv_w_, const float* lru_conv_b_, const uint4* lruw, const float* lru_b_a_, const float* lru_b_x_, const float* sp, const float* HIN_,
                                            const float* lru_norm_, LAS float* hgl  , bf16* MIX_) {
    const int tt = unit & 127, b = unit >> 7, fr = lane_ & 15, q = lane_ >> 4;
    const size_t row0 = (size_t)b * SEQ + tt * 16;
    float ss[4] = {0.f, 0.f, 0.f, 0.f};
#pragma unroll 1
    for (int n = 0; n < 8; ++n) { float av[2][4], uv[2][4];
        lru_tile_block(PROJ_, row0, tt * 16, n, lane_, lru_conv_w_ + l * 1024, lru_conv_b_ + l * 256, lruw, lru_b_a_ + l * 256, lru_b_x_ + l * 256, sp, av, uv);
#pragma unroll
        for (int hf = 0; hf < 2; ++hf) { const int c = 32 * n + 16 * hf + fr;
            float Ap[4], Bp[4]; Ap[0] = av[hf][0]; Bp[0] = uv[hf][0];
#pragma unroll
            for (int g = 1; g < 4; ++g) { Ap[g] = av[hf][g] * Ap[g - 1]; Bp[g] = av[hf][g] * Bp[g - 1] + uv[hf][g]; }
            float hh = HIN_[(size_t)unit * 256 + c];
#pragma unroll
            for (int g = 0; g < 3; ++g) { const float Ag = __shfl(Ap[3], fr + 16 * g), Bg = __shfl(Bp[3], fr + 16 * g); if (g < q) hh = Ag * hh + Bg; }
#pragma unroll
            for (int g = 0; g < 4; ++g) { const float hv = Ap[g] * hh + Bp[g]; const float gt = bf2f(PROJ_[(row0 + 4 * q + g) * NPROJ + PBG + c]); const float v = hv * pg8::gelu_tanh_f(gt); hgl[(4 * q + g) * 256 + c] = v; ss[g] += v * v; } }
    }
    const float* ln = lru_norm_ + l * 256; float rs[4];
#pragma unroll
    for (int g = 0; g < 4; ++g) { float s = ss[g]; s += __shfl_xor(s, 1); s += __shfl_xor(s, 2); s += __shfl_xor(s, 4); s += __shfl_xor(s, 8); rs[g] = 1.f / sqrtf(s * (1.f / 256.f) + EPS); }
    bf16* mix0 = MIX_ + (row0 + 4 * q) * DM + OB + fr;
#pragma unroll 1
    for (int n = 0; n < 8; ++n) { const float gn0 = ln[32 * n + fr], gn1 = ln[32 * n + 16 + fr];
#pragma unroll
        for (int g = 0; g < 4; ++g) { const unsigned w = cvtpk(hgl[(4 * q + g) * 256 + 32 * n + fr] * rs[g] * gn0, hgl[(4 * q + g) * 256 + 32 * n + 16 + fr] * rs[g] * gn1);
            bf16* mp = mix0 + (size_t)g * DM + 32 * n; mp[0] = (bf16)w; mp[16] = (bf16)(w >> 16); } }
}

typedef short v4i16_t __attribute__((ext_vector_type(4)));
struct SwaUnit { int p, b, h, d, res, nb; };
__device__ __forceinline__ SwaUnit swa_decode(int u) { SwaUnit s; s.p = u / 1536; const int v = u % 1536; s.b = v / 96; s.h = (v >> 4) % 6; const int rb = v & 15;
    if (s.p == 0) { s.d = 1; s.res = 0; s.nb = rb; } else if (s.p == 1) { s.d = 4; s.res = rb >> 2; s.nb = rb & 3; } else { s.d = 16; s.res = rb; s.nb = 0; } return s; }
__device__ __forceinline__ void swa_fetch(const SwaUnit& s, int tq, const bf16* __restrict__ PROJ_, u32x4v (&kr)[8], u32x4v (&vr)[8]) {
    const size_t rowb = (size_t)s.b * SEQ;
#pragma unroll
    for (int i = 0; i < 8; ++i) { const int id = tq + 256 * i, row = id >> 3, ch = id & 7;
        if (s.nb > 0 || row >= 128) { const size_t tok = rowb + (size_t)((128 * (s.nb - 1) + row) * s.d + s.res); const bf16* src = PROJ_ + tok * NPROJ + s.h * 64 + 8 * ch;
            kr[i] = *(const u32x4v*)(src + PCK); vr[i] = *(const u32x4v*)(src + PCV); } }
}
__device__ __forceinline__ int swa_gunit(int k, int grp_) { return (k / 192) * 1536 + grp_ * 192 + (k % 192); }
__device__ __forceinline__ void swa_phase(int kfirst, int kstep, int grp_, int wv, int lane_, int tq, LAS unsigned char* ldsK, LAS unsigned char* ldsV, const bf16* __restrict__ PROJ_, bf16* __restrict__ OP_, float* __restrict__ LSE_) {
    u32x4v kr[8], vr[8];
    if (kfirst < 576) swa_fetch(swa_decode(swa_gunit(kfirst, grp_)), tq, PROJ_, kr, vr);
    for (int k = kfirst; k < 576; k += kstep) {
        const SwaUnit s = swa_decode(swa_gunit(k, grp_)); const int p = s.p, h = s.h, d = s.d, res = s.res, nb = s.nb;
        const size_t rowb = (size_t)s.b * SEQ;
        const int r = lane_ & 31, hh = lane_ >> 5;
        const size_t qtok = rowb + (size_t)((128 * nb + 32 * wv + r) * d + res);
        bf16x8v qf[4];
#pragma unroll
        for (int sx = 0; sx < 4; ++sx) qf[sx] = *(const bf16x8v*)(PROJ_ + qtok * NPROJ + PCQ + h * 64 + 16 * sx + 8 * hh);
#pragma unroll
        for (int i = 0; i < 8; ++i) { const int id = tq + 256 * i, row = id >> 3, ch = id & 7;
            if (nb > 0 || row >= 128) { *(LAS u32x4v*)(ldsK + row * 128 + ((ch ^ (row & 7)) << 4)) = kr[i]; *(LAS u32x4v*)(ldsV + row * 128 + (ch << 4)) = vr[i]; } }
        __syncthreads();
        if (k + kstep < 576) swa_fetch(swa_decode(swa_gunit(k + kstep, grp_)), tq, PROJ_, kr, vr);
        f32x16 P[5]; float mx = -1e30f;
#pragma unroll
        for (int kt2 = 0; kt2 < 5; ++kt2) { const int kt = wv + kt2;
            if (nb > 0 || kt >= 4) { f32x16 acc;
#pragma unroll
                for (int i = 0; i < 16; ++i) acc[i] = 0.f;
                const int row = 32 * kt + r;
#pragma unroll
                for (int sx = 0; sx < 4; ++sx) { const bf16x8v kf = *(const LAS bf16x8v*)(ldsK + row * 128 + (((2 * sx + hh) ^ (row & 7)) << 4)); acc = MFMA32(kf, qf[sx], acc); }
#pragma unroll
                for (int i = 0; i < 16; ++i) { const int krow = (i & 3) + 8 * (i >> 2) + 4 * hh; float sv = acc[i];
                    if (kt2 == 0 && krow < r) sv = -1e30f; if (kt2 == 4 && krow > r) sv = -1e30f; P[kt2][i] = sv; mx = fmaxf(mx, sv); }
            } else {
#pragma unroll
                for (int i = 0; i < 16; ++i) P[kt2][i] = -1e30f; }
        }
        mx = fmaxf(mx, __shfl_xor(mx, 32));
        float ls = 0.f;
#pragma unroll
        for (int kt2 = 0; kt2 < 5; ++kt2)
#pragma unroll
            for (int i = 0; i < 16; ++i) { const float e = __builtin_amdgcn_exp2f(P[kt2][i] - mx); P[kt2][i] = e; ls += e; }
        ls += __shfl_xor(ls, 32);
        const float inv = __builtin_amdgcn_rcpf(ls);
        if (hh == 0) LSE_[((size_t)p * M + qtok) * 8 + h] = mx + __builtin_amdgcn_logf(ls);
        f32x16 O0, O1;
#pragma unroll
        for (int i = 0; i < 16; ++i) { O0[i] = 0.f; O1[i] = 0.f; }
        const int i16 = lane_ & 15, g1 = (lane_ >> 4) & 1;
#pragma unroll
        for (int kt2 = 0; kt2 < 5; ++kt2) { const int kt = wv + kt2;
            if (nb > 0 || kt >= 4) {
#pragma unroll
                for (int i = 0; i < 16; ++i) P[kt2][i] *= inv;
#pragma unroll
                for (int sp = 0; sp < 2; ++sp) { const bf16x8v pf = pack8v(P[kt2], 8 * sp);
                    const int key = 32 * kt + 16 * sp + 4 * hh + (i16 >> 2);
#pragma unroll
                    for (int dt = 0; dt < 2; ++dt) { LAS unsigned char* vp = ldsV + key * 128 + (32 * dt + 16 * g1 + 4 * (i16 & 3)) * 2;
                        const v4i16_t lo = __builtin_amdgcn_ds_read_tr16_b64_v4i16((LAS v4i16_t*)vp), hi = __builtin_amdgcn_ds_read_tr16_b64_v4i16((LAS v4i16_t*)(vp + 1024));
                        const bf16x8v vf = {lo[0], lo[1], lo[2], lo[3], hi[0], hi[1], hi[2], hi[3]};
                        if (dt == 0) O0 = MFMA32(pf, vf, O0); else O1 = MFMA32(pf, vf, O1); } }
            }
        }
        { bf16* op0 = OP_ + ((size_t)p * M + rowb + (size_t)((128 * nb + 32 * wv + 4 * hh) * d + res)) * 384 + h * 64 + r; const size_t sd = (size_t)d * 384;
#pragma unroll
            for (int i = 0; i < 16; ++i) { bf16* op = op0 + (size_t)((i & 3) + 8 * (i >> 2)) * sd; const unsigned w = cvtpk(O0[i], O1[i]); op[0] = (bf16)w; op[32] = (bf16)(w >> 16); } }
        __syncthreads();
    }
}
#define x_in ((const float*)a.p[0 + zoff])
#define norm_mix ((const float*)a.p[1 + zoff])
#define w_in ((const float*)a.p[2 + zoff])
#define gla_w_gate ((const float*)a.p[3 + zoff])
#define gla_b_gate ((const float*)a.p[4 + zoff])
#define gla_norm ((const float*)a.p[5 + zoff])
#define lru_conv_w ((const float*)a.p[6 + zoff])
#define lru_conv_b ((const float*)a.p[7 + zoff])
#define lru_w_a ((const float*)a.p[8 + zoff])
#define lru_b_a ((const float*)a.p[9 + zoff])
#define lru_w_x ((const float*)a.p[10 + zoff])
#define lru_b_x ((const float*)a.p[11 + zoff])
#define lru_lambda ((const float*)a.p[12 + zoff])
#define lru_norm ((const float*)a.p[13 + zoff])
#define swa_norm ((const float*)a.p[14 + zoff])
#define w_out ((const float*)a.p[15 + zoff])
#define norm_ffn ((const float*)a.p[16 + zoff])
#define ffn_w_up ((const float*)a.p[17 + zoff])
#define ffn_conv_w ((const float*)a.p[18 + zoff])
#define ffn_conv_b ((const float*)a.p[19 + zoff])
#define ffn_w_down ((const float*)a.p[20 + zoff])
#define norm_final ((const float*)a.p[21 + zoff])
#define X ((float*)a.p[22 + zoff])
#define WSB ((unsigned char*)a.p[23 + zoff])
#define cosT ((float*)(WSB + WS_COS))
#define sinT ((float*)(WSB + WS_SIN))
#define WSET(l_) (((l_) == 0) ? (WSB + WS_W0) : ((unsigned char*)X + (size_t)40 * MiB + (size_t)((l_) - 1) * WSET_BYTES))
#define XB ((bf16*)(WSB + WS_XB))
#define PROJ ((bf16*)(WSB + WS_PROJ))
#define ACT ((bf16*)(WSB + WS_ACT + (size_t)grp * (2 * MiB)))
#define MIX ((bf16*)(WSB + WS_MIX))
#define US ((bf16*)(WSB + WS_US))
#define DBUF ((float*)(WSB + WS_DB))
#define PREBUF ((float*)(WSB + WS_MIX + (size_t)grp * (8 * MiB)) - (size_t)(grp * 16) * 2 * NUP)
#define RAWBUF ((float*)(WSB + WS_MIX + (size_t)grp * (8 * MiB) + MiB) - (size_t)(grp * 16) * 2 * NUP)
#define SSBUF ((bf16*)X)
#define HINBUF ((float*)(WSB + WS_HIN))
#define SSP ((float*)(WSB + WS_SSP))
#define OPBUF ((bf16*)(WSB + WS_OP))
#define LSEBUF ((float*)(WSB + WS_LSE))
#define PBUF ((float*)(WSB + WS_PB))
#define QBUF ((float*)(WSB + WS_QB))
#define tid tid_
#define lane (tid_ & 63)
#define wave (__builtin_amdgcn_readfirstlane(tid_ >> 6))
#define G ((int)gridDim.x)
#define gtid gt_
#define gsz ((int)(gridDim.x * 512))
#define gw ((int)(blockIdx.x * 8) + wave)
#define gwg (wgi * 8 + wave)
#define NGWG (NWG_G * 8)
#define NGW ((int)(gridDim.x * 8))
struct Args { void* p[24]; double inv_freq[8]; int ph_lo, ph_hi; };
#define PHASE_BEGIN int zoff = 0; asm volatile("" : "+s"(zoff)); int tid_; asm volatile("v_mbcnt_lo_u32_b32 %0, -1, 0\n\tv_mbcnt_hi_u32_b32 %0, -1, %0" : "=v"(tid_)); tid_ += wv_s * 64; const int gt_ = (int)(blockIdx.x * 512) + tid_;
#define CONVERT_WEIGHTS(l_) convert_layer_weights((l_), WSET(l_), gtid, gsz, norm_mix, w_in, gla_w_gate, w_out, norm_ffn, ffn_w_up, ffn_w_down, lru_w_a, lru_w_x, lru_lambda)

__global__ void __launch_bounds__(512, 2) fwd(Args a) {
    extern __shared__ __attribute__((aligned(16))) unsigned char lds_raw[];
    LAS unsigned char* lds = (LAS unsigned char*)lds_raw;
    for (int u = (int)threadIdx.x; u < (LDS_BYTES - RING_BYTES) / 4; u += 512) ((LAS unsigned*)(lds + RING_BYTES))[u] = 0u;
    __syncthreads();
    const int wv_s = __builtin_amdgcn_readfirstlane((int)threadIdx.x >> 6);
    const int lo = a.ph_lo, hi = a.ph_hi;
    unsigned* barw; { int zoff = 0; asm volatile("" : "+s"(zoff)); barw = (unsigned*)(WSB + WS_CTL) + CW_BAR; }
    const bool fused = (hi - lo) > 1;
    const int grp = (int)(blockIdx.x & 7), wgi = (int)(blockIdx.x >> 3), NWG_G = (int)(gridDim.x >> 3);
    XcdBarrier barG; barG.bar = barw; barG.x = 0; barG.ng = gridDim.x; barG.st = nullptr;
    XcdBarrier bar; bar.bar = barw + (1 + grp) * XCD_BAR_WORDS; bar.x = 0; bar.ng = (unsigned)NWG_G; bar.st = nullptr;
    if (fused) { barG = xcd_barrier_post(barw, (volatile LAS unsigned*)(lds + MISC_OFF) + 8, gridDim.x); bar = xcd_barrier_post(barw + (1 + grp) * XCD_BAR_WORDS, (volatile LAS unsigned*)(lds + MISC_OFF) + 12, (unsigned)NWG_G); }
#define IN(k) (lo <= (k) && (k) < hi)
#define SEAM() do { if (fused) { XcdBarrier b_ = bar; asm volatile("" : "+s"(b_.bar), "+s"(b_.x)); xcd_barrier(b_); } } while (0)
#define SEAMG() do { if (fused) { XcdBarrier b_ = barG; asm volatile("" : "+s"(b_.bar), "+s"(b_.x)); xcd_barrier(b_); } } while (0)

    if (IN(P_PRO)) { PHASE_BEGIN
        for (int row = gw; row < M; row += NGW) { const f32x4* xr = (const f32x4*)(x_in + (size_t)row * DM) + lane; uint2* xb = (uint2*)(XB + (size_t)row * DM) + lane; float s = 0.f;
#pragma unroll
            for (int j = 0; j < 4; ++j) { const f32x4 v = xr[64 * j]; xb[64 * j] = make_uint2(pk2(v.x, v.y), pk2(v.z, v.w)); s += (v.x * v.x + v.y * v.y) + (v.z * v.z + v.w * v.w); }
            s = wave_sum(s); if (lane < 16) SSP[(size_t)row * 16 + lane] = (lane == 0) ? s : 0.f; }
        for (int t = gtid; t < SEQ; t += gsz) {
#pragma unroll
            for (int j = 0; j < 8; ++j) { double rv = (double)t * a.inv_freq[j] * 0.15915494309189535; rv -= floor(rv);
                cosT[t * 8 + j] = __builtin_amdgcn_cosf((float)rv); sinT[t * 8 + j] = __builtin_amdgcn_sinf((float)rv); } }
        CONVERT_WEIGHTS(0);
    }
    SEAMG();

    for (int l = 0; l < DEPTH; ++l) {
        const int pb = 1 + l * PPL;
        if (IN(pb + L_INPROJ)) { PHASE_BEGIN
            if (l > 0) {
                if (tid == 0) { unsigned* wd = (unsigned*)(WSB + WS_CTL) + CW_WDONE + 64 * l; unsigned sp_ = 0;
                    while (__hip_atomic_load(wd, __ATOMIC_RELAXED, __HIP_MEMORY_SCOPE_AGENT) < 8u) { __builtin_amdgcn_s_sleep(2); if (++sp_ > (1u << 22)) { __hip_atomic_store((unsigned*)(WSB + WS_CTL) + CW_WDONE + 1024, 1u, __ATOMIC_RELAXED, __HIP_MEMORY_SCOPE_AGENT); break; } }
                    __builtin_amdgcn_fence(__ATOMIC_ACQUIRE, "agent"); asm volatile("s_waitcnt vmcnt(0)" ::: "memory"); }
                __syncthreads(); }
            pg8::Gemm g{XB, (const bf16*)(WSET(l) + WO_IN), M, NPROJ, DM}; pg8::StaticOrder S; S.init(M, NPROJ, G, (int)blockIdx.x);
            pg8::EpiScaleBf16 E{PROJ, NPROJ, SSP};
            pg8::gemm_phase<pg8::EpiScaleBf16, pg8::StaticOrder, true, true>(lds, g, S, E, tid);
        }
        SEAM();
        if (IN(pb + L_MA)) { PHASE_BEGIN
            {
                const bf16* __restrict__ pj = PROJ; const float* __restrict__ ct = cosT; const float* __restrict__ st = sinT;
                const int gt_l = wgi * 512 + tid, gsz_l = NWG_G * 512, it0 = grp * (M / 8) * 12, it1 = it0 + (M / 8) * 12;
                for (int b0 = it0 + gt_l; b0 < it1; b0 += 3 * gsz_l) {
                uint4 xa[3], xb_[3]; f32x4 c0[3], c1[3], s0[3], s1[3];
#pragma unroll
                for (int k = 0; k < 3; ++k) { const int it = (b0 + k * gsz_l < it1) ? b0 + k * gsz_l : b0; const int h = it % 6, w = (it / 6) & 1, row = it / 12, t = row & (SEQ - 1);
                    const bf16* p = pj + (size_t)row * NPROJ + (w ? PCK : PCQ) + h * 64; xa[k] = *(const uint4*)p; xb_[k] = *(const uint4*)(p + 8);
                    c0[k] = *(const f32x4*)(ct + t * 8); c1[k] = *(const f32x4*)(ct + t * 8 + 4); s0[k] = *(const f32x4*)(st + t * 8); s1[k] = *(const f32x4*)(st + t * 8 + 4); }
#pragma unroll
                for (int k = 0; k < 3; ++k) { if (k > 0 && b0 + k * gsz_l >= it1) break; const int it = b0 + k * gsz_l; const int h = it % 6, w = (it / 6) & 1, row = it / 12;
                    bf16* p = PROJ + (size_t)row * NPROJ + (w ? PCK : PCQ) + h * 64; float x1[8], x2[8]; unpack8(xa[k], x1); unpack8(xb_[k], x2);
                    const float cc[8] = {c0[k][0], c0[k][1], c0[k][2], c0[k][3], c1[k][0], c1[k][1], c1[k][2], c1[k][3]}, sn_[8] = {s0[k][0], s0[k][1], s0[k][2], s0[k][3], s1[k][0], s1[k][1], s1[k][2], s1[k][3]};
                    float y1[8], y2[8];
#pragma unroll
                    for (int e = 0; e < 8; ++e) { y1[e] = x1[e] * cc[e] - x2[e] * sn_[e]; y2[e] = x2[e] * cc[e] + x1[e] * sn_[e]; }
                    *(uint4*)p = make_uint4(pk2(y1[0], y1[1]), pk2(y1[2], y1[3]), pk2(y1[4], y1[5]), pk2(y1[6], y1[7]));
                    *(uint4*)(p + 8) = make_uint4(pk2(y2[0], y2[1]), pk2(y2[2], y2[3]), pk2(y2[4], y2[5]), pk2(y2[6], y2[7])); }
                }
            }
            for (int u = grp * 512 + gwg; u < (grp + 1) * 512; u += NGWG) gla_m1_unit(u, l, lane, PROJ, gla_b_gate, US, DBUF);
            for (int u = grp * 256 + gwg; u < (grp + 1) * 256; u += NGWG) lru_m1_unit(u, l, lane, PROJ, lru_conv_w, lru_conv_b, (const uint4*)(WSET(l) + WO_LRUW), lru_b_a, lru_b_x, (const float*)(WSET(l) + WO_LRUSP), PBUF, QBUF);
            if (l + 1 < DEPTH) convert_layer_weights(l + 1, WSET(l + 1), grp * NWG_G * 512 + wgi * 512 + tid, gsz, norm_mix, w_in, gla_w_gate, w_out, norm_ffn, ffn_w_up, ffn_w_down, lru_w_a, lru_w_x, lru_lambda);
        }
        SEAM();
        if (IN(pb + L_MA) && l + 1 < DEPTH && wgi == 0 && threadIdx.x == 0) { int zoff = 0; asm volatile("" : "+s"(zoff));
            __hip_atomic_fetch_add((unsigned*)(WSB + WS_CTL) + CW_WDONE + 64 * (l + 1), 1u, __ATOMIC_RELAXED, __HIP_MEMORY_SCOPE_AGENT); }
        if (IN(pb + L_MB)) { PHASE_BEGIN
            { const int nit = 8 * 96 * 6, per = (nit + NWG_G - 1) / NWG_G;
                if (tid < per) { const int it = wgi * per + tid; if (it < nit) gla_m2_item(grp * nit + it, US, SSBUF, DBUF); }
                const int nit2 = 2 * 256, per2 = (nit2 + NWG_G - 1) / NWG_G;
                if (tid >= 256 && tid < 256 + per2) { const int it = wgi * per2 + tid - 256; if (it < nit2) lru_m2_item(grp * nit2 + it, PBUF, QBUF, HINBUF); } }
            { const int half = wave >> 2; LAS unsigned char* lk = lds + half * 65536;
                swa_phase(wgi * 2 + half, 2 * NWG_G, grp, wave & 3, lane, tid & 255, lk, lk + 32768, PROJ, OPBUF, LSEBUF); }
        }
        SEAM();
        if (IN(pb + L_MC)) { PHASE_BEGIN
            for (int u = grp * 512 + gwg; u < (grp + 1) * 512; u += NGWG) gla_m3_unit(u, l, lane, PROJ, gla_b_gate, gla_norm, SSBUF, MIX);
            for (int u = grp * 256 + gwg; u < (grp + 1) * 256; u += NGWG) lru_m3_unit(u, l, lane, PROJ, lru_conv_w, lru_conv_b, (const uint4*)(WSET(l) + WO_LRUW), lru_b_a, lru_b_x, (const float*)(WSET(l) + WO_LRUSP), HINBUF, lru_norm, (LAS float*)(lds + wave * 16384), MIX);
            {
                const float* __restrict__ sn = swa_norm + l * 384; const float* __restrict__ lseb = LSEBUF; const bf16* __restrict__ opb = OPBUF; bf16* __restrict__ mixb = MIX;
                const int cl = lane < 48 ? lane : 47, hd = cl >> 3;
                float sng[8]; { const f32x4 a0 = *(const f32x4*)(sn + 8 * cl), a1 = *(const f32x4*)(sn + 8 * cl + 4); sng[0] = a0[0]; sng[1] = a0[1]; sng[2] = a0[2]; sng[3] = a0[3]; sng[4] = a1[0]; sng[5] = a1[1]; sng[6] = a1[2]; sng[7] = a1[3]; }
                for (int row = grp * (M / 8) + gwg; row < (grp + 1) * (M / 8); row += 2 * NGWG) {
                    float lv[2][3]; uint4 ov[2][3];
#pragma unroll
                    for (int rr = 0; rr < 2; ++rr)
#pragma unroll
                        for (int p = 0; p < 3; ++p) { const size_t r_ = (size_t)p * M + row + rr * NGWG; lv[rr][p] = lseb[r_ * 8 + hd]; ov[rr][p] = *(const uint4*)(opb + r_ * 384 + 8 * cl); }
#pragma unroll
                    for (int rr = 0; rr < 2; ++rr) { const float l0 = lv[rr][0], l1 = lv[rr][1], l2 = lv[rr][2];
                        const float ml = fmaxf(l0, fmaxf(l1, l2)), w0 = __builtin_amdgcn_exp2f(l0 - ml), w1 = __builtin_amdgcn_exp2f(l1 - ml), w2 = __builtin_amdgcn_exp2f(l2 - ml), wi = __builtin_amdgcn_rcpf(w0 + w1 + w2);
                        float o0[8], o1[8], o2[8], e[8]; unpack8(ov[rr][0], o0); unpack8(ov[rr][1], o1); unpack8(ov[rr][2], o2); float s = 0.f;
#pragma unroll
                        for (int k = 0; k < 8; ++k) { e[k] = (w0 * o0[k] + w1 * o1[k] + w2 * o2[k]) * wi; s += e[k] * e[k]; }
                        if (lane >= 48) s = 0.f;
                        const float rs = __builtin_amdgcn_rsqf(wave_sum(s) * (1.f / 384.f) + EPS);
                        if (lane < 48) *(uint4*)(mixb + (size_t)(row + rr * NGWG) * DM + OC + 8 * cl) = make_uint4(pk2(e[0] * rs * sng[0], e[1] * rs * sng[1]), pk2(e[2] * rs * sng[2], e[3] * rs * sng[3]), pk2(e[4] * rs * sng[4], e[5] * rs * sng[5]), pk2(e[6] * rs * sng[6], e[7] * rs * sng[7])); }
                }
            }
        }
        SEAM();
        if (IN(pb + L_OUTPROJ)) { PHASE_BEGIN
            pg8::Gemm g{MIX, (const bf16*)(WSET(l) + WO_OUT), M, DM, DM}; pg8::StaticOrder S; S.init(M, DM, G, (int)blockIdx.x);
            pg8::EpiResid E{XB, DM, SSP};
            pg8::gemm_phase<pg8::EpiResid, pg8::StaticOrder, true, true>(lds, g, S, E, tid);
        }
        SEAM();
        if (IN(pb + L_UP)) { PHASE_BEGIN
            pg8::Gemm g{XB, (const bf16*)(WSET(l) + WO_UP), M, NUP, DM}; pg8::StaticOrder S; S.init(M, NUP, G, (int)blockIdx.x);
            pg8::EpiFfnUp E{ACT, SSP, ffn_conv_w + (size_t)l * 3 * NUP, ffn_conv_b + (size_t)l * NUP, PREBUF, RAWBUF, (LAS float*)(lds + HALO_OFF), FFN, NUP};
            pg8::gemm_phase<pg8::EpiFfnUp, pg8::StaticOrder, true, true>(lds, g, S, E, tid);
        }
        SEAM();
        if (IN(pb + L_DOWN)) { PHASE_BEGIN
            pg8::Gemm g{ACT, (const bf16*)(WSET(l) + WO_DN), M, DM, FFN}; pg8::StaticOrder S; S.init(M, DM, G, (int)blockIdx.x);
            {
                const float* cw = ffn_conv_w + (size_t)l * 3 * NUP; pg8::Unit uu;
                for (int ui = 0; S.next(ui, uu); ++ui) { const int pm = uu.pm; if ((pm & 7) == 0) continue;
                    const float* __restrict__ pre0 = PREBUF + (size_t)(pm * 2) * NUP; const float* __restrict__ r0 = RAWBUF + (size_t)((pm - 1) * 2) * NUP; const float* __restrict__ r1 = r0 + NUP; const float* __restrict__ cwr = cw;
                    bf16* __restrict__ act0 = ACT + (size_t)(pm * 256) * FFN;
                    for (int j = tid; j < FFN; j += 512) {
                        const float pv0 = pre0[j], pg0 = pre0[FFN + j], pv1 = pre0[NUP + j], pg1 = pre0[NUP + FFN + j];
                        const float a0v = r0[j], a0g = r0[FFN + j], a1v = r1[j], a1g = r1[FFN + j];
                        const float w0v = cwr[j], w0g = cwr[FFN + j], w1v = cwr[NUP + j], w1g = cwr[NUP + FFN + j];
                        const float v0 = pv0 + w1v * a1v + w0v * a0v, g0 = pg0 + w1g * a1g + w0g * a0g, v1 = pv1 + w0v * a1v, g1 = pg1 + w0g * a1g;
                        act0[j] = f2bf(gelu_tanh(g0) * v0); act0[FFN + j] = f2bf(gelu_tanh(g1) * v1); } }
                asm volatile("s_waitcnt vmcnt(0)" ::: "memory"); __syncthreads();
            }
            pg8::EpiResid E{XB, DM, SSP};
            pg8::gemm_phase<pg8::EpiResid, pg8::StaticOrder, true, true>(lds, g, S, E, tid);
        }
        SEAM();
    }
    SEAMG();
    if (IN(P_FIN)) { PHASE_BEGIN
        for (int row = grp * (M / 8) + gwg; row < (grp + 1) * (M / 8); row += NGWG) { f32x4* xo = (f32x4*)(X + (size_t)row * DM) + lane; const uint2* xb = (const uint2*)(XB + (size_t)row * DM) + lane; const f32x4* sp = (const f32x4*)(SSP + (size_t)row * 16);
            const f32x4 p0 = sp[0], p1 = sp[1], p2 = sp[2], p3 = sp[3]; const f32x4 ps = (p0 + p1) + (p2 + p3);
            const float rs = 1.f / sqrtf(((ps[0] + ps[1]) + (ps[2] + ps[3])) * (1.f / DM) + EPS);
#pragma unroll
            for (int j = 0; j < 4; ++j) { const f32x4 g4 = ((const f32x4*)norm_final)[lane + 64 * j]; const uint2 u = xb[64 * j];
                f32x4 v; v.x = __uint_as_float(u.x << 16); v.y = __uint_as_float(u.x & 0xffff0000u); v.z = __uint_as_float(u.y << 16); v.w = __uint_as_float(u.y & 0xffff0000u); xo[64 * j] = v * rs * g4; } }
    }
#undef IN
#undef SEAM
}

extern "C" void kernel_launch(void* const* d_in, const int* in_sizes, int n_in, void* d_out, int out_size, void* d_ws, size_t ws_size, hipStream_t stream) {
    static int grid = 0;
    if (grid == 0) {
        if (n_in != 22 || in_sizes[0] != M * DM || out_size != M * DM || ws_size < WS_END) { fprintf(stderr, "kernel_launch: unexpected shapes: n_in %d in0 %d out %d ws %zu (need %zu)\n", n_in, n_in > 0 ? in_sizes[0] : -1, out_size, ws_size, (size_t)WS_END); grid = -1; return; }
        int dev = 0, cus = 0, per_cu = 0;
        if (hipGetDevice(&dev) != hipSuccess || hipDeviceGetAttribute(&cus, hipDeviceAttributeMultiprocessorCount, dev) != hipSuccess) { grid = -1; return; }
        if (hipFuncSetAttribute((const void*)fwd, hipFuncAttributeMaxDynamicSharedMemorySize, LDS_BYTES) != hipSuccess) { fprintf(stderr, "kernel_launch: hipFuncSetAttribute failed\n"); grid = -1; return; }
        if (hipOccupancyMaxActiveBlocksPerMultiprocessor(&per_cu, (const void*)fwd, 512, LDS_BYTES) != hipSuccess || per_cu < 1) fprintf(stderr, "kernel_launch: occupancy query says %d\n", per_cu);
        (void)hipGetLastError();
        grid = cus;
    }
    if (grid < 0) return;
    (void)hipMemsetAsync((char*)d_ws + WS_CTL, 0, CTL_ZERO_BYTES, stream);
    Args a{};
    for (int i = 0; i < 22; ++i) a.p[i] = d_in[i];
    a.p[22] = d_out; a.p[23] = d_ws;
    const double invf[8] = {1.0, 0.19392274474868576, 0.03760603093086393, 0.007292664737217109, 0.001414213562373095, 0.0002742481756762073, 5.318295896944988e-05, 1.031338537721246e-05};
    for (int j = 0; j < 8; ++j) a.inv_freq[j] = invf[j];
#if MK_ONE_LAUNCH
    a.ph_lo = 0; a.ph_hi = NPH;
    hipLaunchKernelGGL(fwd, dim3(grid), dim3(512), LDS_BYTES, stream, a);
#else
    for (int p = 0; p < NPH; ++p) { a.ph_lo = p; a.ph_hi = p + 1; hipLaunchKernelGGL(fwd, dim3(grid), dim3(512), LDS_BYTES, stream, a); }
#endif
}
```
